# Optimizing an MI355X kernel written in HIP

```python
import math
import jax, jax.numpy as jnp
from jax import lax
import numpy as np

D_MODEL = 1024
BATCH = 2
SEQ = 16384
DEPTH = 2
DEC_BATCH = 8
DEC_SEQ = 2048
PAST_LEN = 128

GRID_W = 64
HEAD_DIM = 64
N_EVEN = (DEPTH + 1) // 2
N_ODD = DEPTH // 2
DIFF_HEADS = 4
DIFF_VDIM = 2 * HEAD_DIM
GQA_HEADS = 8
GQA_KV_HEADS = 2
GQA_GROUP = GQA_HEADS // GQA_KV_HEADS
NA_HEADS = D_MODEL // HEAD_DIM
NA_KH_MAX = 8
NA_KW = 16
NA_BLOCK = GRID_W
DIFF_QK_W = DIFF_HEADS * 2 * HEAD_DIM
DIFF_V_W = DIFF_HEADS * DIFF_VDIM
GQA_Q_W = GQA_HEADS * HEAD_DIM
GQA_KV_W = GQA_KV_HEADS * HEAD_DIM
EVEN_SPLITS = [DIFF_QK_W, 2 * DIFF_QK_W, 2 * DIFF_QK_W + DIFF_V_W,
               2 * DIFF_QK_W + DIFF_V_W + GQA_Q_W,
               2 * DIFF_QK_W + DIFF_V_W + GQA_Q_W + GQA_KV_W]
EVEN_IN_W = 2 * DIFF_QK_W + DIFF_V_W + GQA_Q_W + 2 * GQA_KV_W
MIX_W = DIFF_V_W + GQA_Q_W
NA_W = NA_HEADS * HEAD_DIM
D_FF = 2816
CONV_W = 3
Q_BLOCK = 128
ROPE_THETA = 10000.0
EPS = 1e-6
SUBLN_EPS = 1e-5

kernel_name = "hybrid_diffattn_gqa_natten_encoder"


def rmsnorm(x, g, eps=EPS):
    xf = x.astype(jnp.float32)
    y = xf * lax.rsqrt(jnp.mean(xf * xf, axis=-1, keepdims=True) + eps)
    return (y * g.astype(jnp.float32)).astype(x.dtype)


def rope_1d(seq, dim):
    inv = ROPE_THETA ** (-jnp.arange(0, dim, 2, dtype=jnp.float32) / dim)
    t = jnp.arange(seq, dtype=jnp.float32)
    return t[:, None] * inv[None, :]


def rope_axial(seq, dim):
    half = dim // 2
    inv = ROPE_THETA ** (-jnp.arange(0, half, 2, dtype=jnp.float32) / half)
    t = jnp.arange(seq, dtype=jnp.int32)
    row = (t // GRID_W).astype(jnp.float32)
    col = (t % GRID_W).astype(jnp.float32)
    return jnp.concatenate([row[:, None] * inv[None, :], col[:, None] * inv[None, :]], axis=-1)


def apply_rope(x, ang):
    shape = (ang.shape[0],) + (1,) * (x.ndim - 3) + (ang.shape[1],)
    cos = jnp.cos(ang).reshape(shape).astype(x.dtype)
    sin = jnp.sin(ang).reshape(shape).astype(x.dtype)
    x1, x2 = jnp.split(x, 2, axis=-1)
    return jnp.concatenate([x1 * cos - x2 * sin, x2 * cos + x1 * sin], axis=-1)


def even_mixer(h, w_in, w_out, lam_vec, subln_g, qk_g, layer_idx):
    b, s, _ = h.shape
    nb = s // Q_BLOCK
    proj = h @ w_in
    qa, ka, va, qb, kb, vb = jnp.split(proj, EVEN_SPLITS, axis=-1)
    ang1 = rope_1d(s, HEAD_DIM)
    qa = apply_rope(qa.reshape(b, s, DIFF_HEADS, 2, HEAD_DIM), ang1)
    ka = apply_rope(ka.reshape(b, s, DIFF_HEADS, 2, HEAD_DIM), ang1)
    va = va.reshape(b, s, DIFF_HEADS, DIFF_VDIM)
    lambda_init = 0.8 - 0.6 * math.exp(-0.3 * layer_idx)
    lf = lam_vec.astype(jnp.float32)
    lam = jnp.exp(jnp.sum(lf[0] * lf[1])) - jnp.exp(jnp.sum(lf[2] * lf[3])) + lambda_init
    ang2 = rope_axial(s, HEAD_DIM)
    qb = apply_rope(rmsnorm(qb.reshape(b, s, GQA_KV_HEADS, GQA_GROUP, HEAD_DIM), qk_g[0]), ang2)
    kb = apply_rope(rmsnorm(kb.reshape(b, s, GQA_KV_HEADS, HEAD_DIM), qk_g[1]), ang2)
    vb = vb.reshape(b, s, GQA_KV_HEADS, HEAD_DIM)
    scale = HEAD_DIM ** -0.5

    def block(qs):
        qa_b, qb_b = qs
        sa = jnp.einsum('bqhcd,bkhcd->bhcqk', qa_b, ka).astype(jnp.float32) * scale
        pa = jax.nn.softmax(sa, axis=-1)
        pdiff = pa[:, :, 0] - lam * pa[:, :, 1]
        oa = jnp.einsum('bhqk,bkhe->bqhe', pdiff.astype(va.dtype), va)
        oa = rmsnorm(oa, subln_g, eps=SUBLN_EPS) * (1.0 - lambda_init)
        sb = jnp.einsum('bqngd,bknd->bngqk', qb_b, kb).astype(jnp.float32) * scale
        pb = jax.nn.softmax(sb, axis=-1)
        ob = jnp.einsum('bngqk,bknd->bqngd', pb.astype(vb.dtype), vb)
        return jnp.concatenate([oa.reshape(b, Q_BLOCK, DIFF_V_W),
                                ob.reshape(b, Q_BLOCK, GQA_Q_W)], axis=-1)

    qa_blk = qa.reshape(b, nb, Q_BLOCK, DIFF_HEADS, 2, HEAD_DIM).swapaxes(0, 1)
    qb_blk = qb.reshape(b, nb, Q_BLOCK, GQA_KV_HEADS, GQA_GROUP, HEAD_DIM).swapaxes(0, 1)
    o = lax.map(block, (qa_blk, qb_blk))
    o = o.swapaxes(0, 1).reshape(b, s, MIX_W)
    return o @ w_out


def na_indices(s):
    rows = s // GRID_W
    kh = min(NA_KH_MAX, rows)
    t = jnp.arange(s, dtype=jnp.int32)
    r = t // GRID_W
    col = t % GRID_W
    rs = jnp.clip(r - kh // 2, 0, rows - kh)
    cs = jnp.clip(col - NA_KW // 2, 0, GRID_W - NA_KW)
    kr = rs[:, None, None] + jnp.arange(kh, dtype=jnp.int32)[None, :, None]
    kc = cs[:, None, None] + jnp.arange(NA_KW, dtype=jnp.int32)[None, None, :]
    idx = (kr * GRID_W + kc).reshape(s, kh * NA_KW)
    dr = kr - r[:, None, None] + (NA_KH_MAX - 1)
    dc = kc - col[:, None, None] + (NA_KW - 1)
    bias_idx = (dr * (2 * NA_KW - 1) + dc).reshape(s, kh * NA_KW)
    return idx, bias_idx


def odd_mixer(h, w_qkv, rpb, w_out):
    b, s, _ = h.shape
    nb = s // NA_BLOCK
    qkv = (h @ w_qkv).reshape(b, s, 3, NA_HEADS, HEAD_DIM)
    q, k, v = qkv[:, :, 0], qkv[:, :, 1], qkv[:, :, 2]
    idx, bias_idx = na_indices(s)
    n_keys = idx.shape[-1]
    rpb_flat = rpb.reshape(NA_HEADS, -1)
    scale = HEAD_DIM ** -0.5

    def block(xs):
        q_b, idx_b, bidx_b = xs
        kg = jnp.take(k, idx_b, axis=1)
        vg = jnp.take(v, idx_b, axis=1)
        bias = rpb_flat[:, bidx_b].astype(jnp.float32)
        sc = jnp.einsum('bqhd,bqkhd->bhqk', q_b, kg).astype(jnp.float32) * scale + bias[None]
        p = jax.nn.softmax(sc, axis=-1)
        o = jnp.einsum('bhqk,bqkhd->bqhd', p.astype(v.dtype), vg)
        return o.reshape(b, NA_BLOCK, NA_W)

    q_blk = q.reshape(b, nb, NA_BLOCK, NA_HEADS, HEAD_DIM).swapaxes(0, 1)
    o = lax.map(block, (q_blk, idx.reshape(nb, NA_BLOCK, n_keys),
                        bias_idx.reshape(nb, NA_BLOCK, n_keys)))
    o = o.swapaxes(0, 1).reshape(b, s, NA_W)
    return o @ w_out


def conv_ffn(h, w_up, conv_w, conv_b, w_down):
    u = h @ w_up
    up = jnp.pad(u, ((0, 0), (1, 1), (0, 0)))
    u = up[:, :-2] * conv_w[0] + up[:, 1:-1] * conv_w[1] + up[:, 2:] * conv_w[2] + conv_b
    gate, val = jnp.split(u, 2, axis=-1)
    return (jax.nn.silu(gate) * val) @ w_down


def trunk(x, c, ada_w, ada_b, norm_g, even_w_in, even_w_out, diff_lambda, diff_subln_g,
          gqa_qk_g, odd_w_qkv, odd_rpb, odd_w_out, ffn_w_up, ffn_conv_w, ffn_conv_b,
          ffn_w_down, final_g):
    c_act = jax.nn.silu(c)
    for l in range(DEPTH):
        mod = c_act @ ada_w[l] + ada_b[l]
        sh1, sc1, g1, sh2, sc2, g2 = [m[:, None, :] for m in jnp.split(mod, 6, axis=-1)]
        h = rmsnorm(x, norm_g[l, 0]) * (1.0 + sc1) + sh1
        if l % 2 == 0:
            e = l // 2
            m = even_mixer(h, even_w_in[e], even_w_out[e], diff_lambda[e], diff_subln_g[e],
                           gqa_qk_g[e], l)
        else:
            o = l // 2
            m = odd_mixer(h, odd_w_qkv[o], odd_rpb[o], odd_w_out[o])
        x = x + g1 * m
        h = rmsnorm(x, norm_g[l, 1]) * (1.0 + sc2) + sh2
        x = x + g2 * conv_ffn(h, ffn_w_up[l], ffn_conv_w[l], ffn_conv_b[l], ffn_w_down[l])
    return rmsnorm(x, final_g)


def setup_inputs(seed: int = 0) -> dict:
    key = jax.random.key(seed)
    ks = jax.random.split(key, 20)
    D = D_MODEL

    def nrm(k, shape, scale):
        return jax.random.normal(k, shape, jnp.float32) * scale

    return {
        "x_prompt": nrm(ks[0], (BATCH, SEQ, D), 1.0),
        "x_sample": nrm(ks[1], (DEC_BATCH, DEC_SEQ, D), 1.0),
        "c_prompt": nrm(ks[2], (BATCH, D), 1.0),
        "c_sample": nrm(ks[3], (DEC_BATCH, D), 1.0),
        "ada_w": nrm(ks[4], (DEPTH, D, 6 * D), D ** -0.5),
        "ada_b": nrm(ks[5], (DEPTH, 6 * D), 0.02),
        "norm_g": 1.0 + nrm(ks[6], (DEPTH, 2, D), 0.02),
        "even_w_in": nrm(ks[7], (N_EVEN, D, EVEN_IN_W), D ** -0.5),
        "even_w_out": nrm(ks[8], (N_EVEN, MIX_W, D), MIX_W ** -0.5),
        "diff_lambda": nrm(ks[9], (N_EVEN, 4, HEAD_DIM), 0.1),
        "diff_subln_g": 1.0 + nrm(ks[10], (N_EVEN, DIFF_VDIM), 0.02),
        "gqa_qk_g": 1.0 + nrm(ks[11], (N_EVEN, 2, HEAD_DIM), 0.02),
        "odd_w_qkv": nrm(ks[12], (N_ODD, D, 3 * NA_W), D ** -0.5),
        "odd_rpb": nrm(ks[13], (N_ODD, NA_HEADS, 2 * NA_KH_MAX - 1, 2 * NA_KW - 1), 0.5),
        "odd_w_out": nrm(ks[14], (N_ODD, NA_W, D), NA_W ** -0.5),
        "ffn_w_up": nrm(ks[15], (DEPTH, D, 2 * D_FF), D ** -0.5),
        "ffn_conv_w": nrm(ks[16], (DEPTH, CONV_W, 2 * D_FF), CONV_W ** -0.5),
        "ffn_conv_b": nrm(ks[17], (DEPTH, 2 * D_FF), 0.02),
        "ffn_w_down": nrm(ks[18], (DEPTH, D_FF, D), D_FF ** -0.5),
        "final_g": 1.0 + nrm(ks[19], (D,), 0.02),
    }


def reference(x_prompt, x_sample, c_prompt, c_sample, ada_w, ada_b, norm_g, even_w_in,
              even_w_out, diff_lambda, diff_subln_g, gqa_qk_g, odd_w_qkv, odd_rpb, odd_w_out,
              ffn_w_up, ffn_conv_w, ffn_conv_b, ffn_w_down, final_g):
    y_prompt = trunk(x_prompt, c_prompt, ada_w, ada_b, norm_g, even_w_in, even_w_out,
                     diff_lambda, diff_subln_g, gqa_qk_g, odd_w_qkv, odd_rpb, odd_w_out,
                     ffn_w_up, ffn_conv_w, ffn_conv_b, ffn_w_down, final_g)
    y_sample = trunk(x_sample, c_sample, ada_w, ada_b, norm_g, even_w_in, even_w_out,
                     diff_lambda, diff_subln_g, gqa_qk_g, odd_w_qkv, odd_rpb, odd_w_out,
                     ffn_w_up, ffn_conv_w, ffn_conv_b, ffn_w_down, final_g)
    return (y_prompt, y_sample)
```

```cpp
#include <hip/hip_runtime.h>
#include <hip/hip_cooperative_groups.h>
#include <cstdio>
namespace cg = cooperative_groups;

typedef unsigned short u16;
typedef __attribute__((ext_vector_type(8))) short bf16x8;
typedef __attribute__((ext_vector_type(16))) float f32x16;
typedef __attribute__((ext_vector_type(4))) unsigned u32x4;
typedef __attribute__((ext_vector_type(2))) unsigned u32x2;
typedef __attribute__((ext_vector_type(2))) float f32x2;
typedef __attribute__((ext_vector_type(2))) __bf16 bf16v2;

#define DI __device__ __forceinline__
#define MFMA(a, b, c) __builtin_amdgcn_mfma_f32_32x32x16_bf16((a), (b), (c), 0, 0, 0)

#ifndef ONE_LAUNCH
#define ONE_LAUNCH 1
#endif

constexpr int NTHR = 512;
constexpr int DM = 1024;
constexpr int NTOK = 49152;
constexpr int NTOK_P = 32768;
constexpr int SP = 16384, SS = 2048;
constexpr int DFF = 2816;
constexpr int QK0_LD = 1664;
constexpr int QK1_LD = 2048;
constexpr int NPHASE = 16;

constexpr size_t OFF_WT_IN = 0;
constexpr size_t OFF_WT_OUT0 = OFF_WT_IN + (size_t)2304 * 1024 * 2;
constexpr size_t OFF_WT_UP0 = OFF_WT_OUT0 + (size_t)1024 * 1024 * 2;
constexpr size_t OFF_WT_UP1 = OFF_WT_UP0 + (size_t)5632 * 1024 * 2;
constexpr size_t OFF_WT_DN0 = OFF_WT_UP1 + (size_t)5632 * 1024 * 2;
constexpr size_t OFF_WT_DN1 = OFF_WT_DN0 + (size_t)1024 * 2816 * 2;
constexpr size_t OFF_WT_QKV = OFF_WT_DN1 + (size_t)1024 * 2816 * 2;
constexpr size_t OFF_WT_OUT1 = OFF_WT_QKV + (size_t)3072 * 1024 * 2;
constexpr size_t OFF_MOD = OFF_WT_OUT1 + (size_t)1024 * 1024 * 2;
constexpr size_t OFF_CS1 = OFF_MOD + (size_t)2 * 10 * 6144 * 4;
constexpr size_t OFF_CS2 = OFF_CS1 + (size_t)16384 * 32 * 8;
constexpr size_t OFF_H = OFF_CS2 + (size_t)16384 * 32 * 8;
constexpr size_t OFF_BIG = OFF_H + (size_t)NTOK * 1024 * 2;
constexpr size_t BIG_BYTES = (size_t)NTOK * 3072 * 2;
constexpr size_t OFF_VT0 = OFF_BIG + (size_t)NTOK * QK0_LD * 2;
constexpr size_t OFF_VT1 = OFF_BIG + (size_t)NTOK * QK1_LD * 2;
constexpr size_t OFF_STASH = OFF_BIG + BIG_BYTES;
constexpr size_t STASH_PER_BLOCK = (size_t)8 * 64 * 64 * 4;
constexpr size_t OFF_BAR = OFF_STASH + 256 * STASH_PER_BLOCK;
constexpr size_t OFF_ZERO = OFF_BAR + 4096;
constexpr size_t WS_NEEDED = OFF_ZERO + 256;

constexpr int LDS_BYTES = 133120;
constexpr float QK_SCALE_LOG2 = 0.125f * 1.4426950408889634f;

__device__ const float INV1[32] = {1.000000000e+00f, 7.498942614e-01f, 5.623413324e-01f, 4.216965139e-01f, 3.162277639e-01f, 2.371373773e-01f, 1.778279394e-01f, 1.333521307e-01f, 1.000000015e-01f, 7.498941571e-02f, 5.623413250e-02f, 4.216965288e-02f, 3.162277490e-02f, 2.371373773e-02f, 1.778279431e-02f, 1.333521493e-02f, 9.999999776e-03f, 7.498941850e-03f, 5.623413250e-03f, 4.216964822e-03f, 3.162277630e-03f, 2.371373586e-03f, 1.778279431e-03f, 1.333521446e-03f, 1.000000047e-03f, 7.498942432e-04f, 5.623413017e-04f, 4.216965172e-04f, 3.162277571e-04f, 2.371373703e-04f, 1.778279402e-04f, 1.333521504e-04f};
__device__ const float INV2[16] = {1.000000000e+00f, 5.623413324e-01f, 3.162277639e-01f, 1.778279394e-01f, 1.000000015e-01f, 5.623413250e-02f, 3.162277490e-02f, 1.778279431e-02f, 9.999999776e-03f, 5.623413250e-03f, 3.162277630e-03f, 1.778279431e-03f, 1.000000047e-03f, 5.623413017e-04f, 3.162277571e-04f, 1.778279402e-04f};

struct Params {
  const float *x_prompt, *x_sample, *c_prompt, *c_sample, *ada_w, *ada_b, *norm_g, *even_w_in, *even_w_out,
      *diff_lambda, *diff_subln_g, *gqa_qk_g, *odd_w_qkv, *odd_rpb, *odd_w_out, *ffn_w_up, *ffn_conv_w,
      *ffn_conv_b, *ffn_w_down, *final_g;
  float* out;
  char* ws;
};

DI unsigned pk_bf16(float a, float b) {
  f32x2 v = {a, b};
  bf16v2 r = __builtin_convertvector(v, bf16v2);
  return __builtin_bit_cast(unsigned, r);
}
DI u16 to_bf16(float a) { return (u16)(pk_bf16(a, 0.f) & 0xffffu); }
DI float bf16_to_f(u16 v) { return __uint_as_float(((unsigned)v) << 16); }
DI void half_swap(u32x2& X, u32x2& Y) {
  typedef __attribute__((ext_vector_type(2))) unsigned u2_;
  const u2_ a = __builtin_amdgcn_permlane32_swap(X.x, Y.x, false, false);
  const u2_ b = __builtin_amdgcn_permlane32_swap(X.y, Y.y, false, false);
  X.x = a.x; Y.x = a.y; X.y = b.x; Y.y = b.y;
}
DI int opaque_tid() { int t = threadIdx.x; asm volatile("" : "+v"(t)); return t; }
DI float fexp2(float x) { return __builtin_amdgcn_exp2f(x); }
DI int swz(int row, int chunk) { return row * 128 + ((chunk ^ ((row >> 1) & 7)) << 4); }
DI int crow(int i, int h) { return (i & 3) + 8 * (i >> 2) + 4 * h; }
DI void seq_of_token(int t, int& bb, int& tokbase, int& S) {
  if (t < NTOK_P) { bb = t >> 14; tokbase = bb << 14; S = SP; }
  else { int u = (t - NTOK_P) >> 11; bb = 2 + u; tokbase = NTOK_P + (u << 11); S = SS; }
}
DI const float* xin_row(const Params& p, int t) {
  return (t < NTOK_P) ? (p.x_prompt + (size_t)t * DM) : (p.x_sample + (size_t)(t - NTOK_P) * DM);
}
DI int logical_index(int it) {
  const int G = gridDim.x, b = blockIdx.x;
  if ((G & 7) == 0) return it * G + (b & 7) * (G >> 3) + (b >> 3);
  return it * G + b;
}

DI void phase0_item(const Params& p, int item, char* lds) {
  const int tid = opaque_tid();
  if (item < 192) {
    const int l = item / 96, jc = item % 96;
    float* cact = (float*)lds;
    float* red = (float*)(lds + 40960);
    for (int e = tid; e < 10240; e += NTHR) {
      int bb = e >> 10, k = e & 1023;
      float c = (bb < 2) ? p.c_prompt[bb * 1024 + k] : p.c_sample[(bb - 2) * 1024 + k];
      cact[e] = c / (1.f + __expf(-c));
    }
    __syncthreads();
    const int col = tid & 63, kg = tid >> 6;
    float acc[10];
#pragma unroll
    for (int b = 0; b < 10; ++b) acc[b] = 0.f;
    const float* w = p.ada_w + (size_t)l * 1024 * 6144 + (size_t)(kg * 128) * 6144 + jc * 64 + col;
#pragma unroll 8
    for (int k = 0; k < 128; ++k) {
      float wv = w[(size_t)k * 6144];
#pragma unroll
      for (int b = 0; b < 10; ++b) acc[b] += cact[b * 1024 + kg * 128 + k] * wv;
    }
#pragma unroll
    for (int b = 0; b < 10; ++b) red[(kg * 10 + b) * 64 + col] = acc[b];
    __syncthreads();
    for (int e = tid; e < 640; e += NTHR) {
      int b = e >> 6, c = e & 63;
      float s = p.ada_b[l * 6144 + jc * 64 + c];
#pragma unroll
      for (int g = 0; g < 8; ++g) s += red[(g * 10 + b) * 64 + c];
      ((float*)(p.ws + OFF_MOD))[(l * 10 + b) * 6144 + jc * 64 + c] = s;
    }
    __syncthreads();
    return;
  }
  item -= 192;
  if (item < 6080) {
    const float* src; u16* dst; int K, N, perm = 0, tl;
    if (item < 576) { src = p.even_w_in; dst = (u16*)(p.ws + OFF_WT_IN); K = 1024; N = 2304; tl = item; }
    else if (item < 832) { src = p.even_w_out; dst = (u16*)(p.ws + OFF_WT_OUT0); K = 1024; N = 1024; tl = item - 576; }
    else if (item < 2240) { src = p.ffn_w_up; dst = (u16*)(p.ws + OFF_WT_UP0); K = 1024; N = 5632; perm = 1; tl = item - 832; }
    else if (item < 3648) { src = p.ffn_w_up + (size_t)1024 * 5632; dst = (u16*)(p.ws + OFF_WT_UP1); K = 1024; N = 5632; perm = 1; tl = item - 2240; }
    else if (item < 4352) { src = p.ffn_w_down; dst = (u16*)(p.ws + OFF_WT_DN0); K = 2816; N = 1024; tl = item - 3648; }
    else if (item < 5056) { src = p.ffn_w_down + (size_t)2816 * 1024; dst = (u16*)(p.ws + OFF_WT_DN1); K = 2816; N = 1024; tl = item - 4352; }
    else if (item < 5824) { src = p.odd_w_qkv; dst = (u16*)(p.ws + OFF_WT_QKV); K = 1024; N = 3072; tl = item - 5056; }
    else { src = p.odd_w_out; dst = (u16*)(p.ws + OFF_WT_OUT1); K = 1024; N = 1024; tl = item - 5824; }
    const int ntn = N >> 6;
    const int k0 = (tl / ntn) << 6, n0 = (tl % ntn) << 6;
    float* T = (float*)lds;
    const int a = tid >> 6, c = tid & 63;
#pragma unroll
    for (int i = 0; i < 8; ++i) {
      int kk = a + 8 * i;
      T[kk * 65 + c] = src[(size_t)(k0 + kk) * N + n0 + c];
    }
    __syncthreads();
#pragma unroll
    for (int i = 0; i < 8; ++i) {
      int nn = a + 8 * i;
      int n = n0 + nn;
      int row = n;
      if (perm) {
        if (n < DFF) row = ((n >> 7) << 8) + (n & 127);
        else { int n2 = n - DFF; row = ((n2 >> 7) << 8) + 128 + (n2 & 127); }
      }
      dst[(size_t)row * K + k0 + c] = to_bf16(T[c * 65 + nn]);
    }
    __syncthreads();
    return;
  }
  item -= 6080;
  {
#pragma unroll
    for (int i = 0; i < 8; ++i) {
      int e = item * 4096 + i * 512 + tid;
      int tab = e >> 19;
      int ee = e & 524287;
      int t = ee >> 5, j = ee & 31;
      float ang;
      if (tab == 0) ang = (float)t * INV1[j];
      else ang = (j < 16) ? (float)(t >> 6) * INV2[j] : (float)(t & 63) * INV2[j - 16];
      double rev = (double)ang * 0.15915494309189533577;
      double fr = rev - rint(rev);
      float f = (float)fr;
      f32x2 cs = {__builtin_amdgcn_cosf(f), __builtin_amdgcn_sinf(f)};
      ((f32x2*)(p.ws + (tab ? OFF_CS2 : OFF_CS1)))[ee] = cs;
    }
  }
}

DI void phase_ln(const Params& p, int layer, int sub, bool first, bool final_, const u16* M, int glayer, int goff) {
  const int tid = opaque_tid(), lane = tid & 63, w = tid >> 6;
  const float* gn = final_ ? p.final_g : (p.norm_g + (layer * 2 + sub) * 1024);
  const float* mod = (const float*)(p.ws + OFF_MOD);
  u16* H = (u16*)(p.ws + OFF_H);
  const int nw = gridDim.x * 8, gw = blockIdx.x * 8 + w;
  const int rows_per = (NTOK + nw - 1) / nw;
  const int r0 = gw * rows_per;
  const int r1 = (r0 + rows_per < NTOK) ? (r0 + rows_per) : NTOK;
  if (r0 >= r1) return;
  auto load_row = [&](int row, float4 (&v)[4], u32x2 (&mm)[4]) {
    const float* xr = first ? xin_row(p, row) : (p.out + (size_t)row * DM);
#pragma unroll
    for (int j = 0; j < 4; ++j) v[j] = *(const float4*)(xr + j * 256 + lane * 4);
    if (M) {
#pragma unroll
      for (int j = 0; j < 4; ++j) mm[j] = *(const u32x2*)(M + (size_t)row * DM + j * 256 + lane * 4);
    }
  };
  float4 pg[4], psh[4], pgm[4];
  int cur_bb = -1;
  float4 v[4], vn[4], vn2[4];
  u32x2 mm[4], mmn[4], mmn2[4];
#pragma unroll
  for (int j = 0; j < 4; ++j) {
    mm[j] = (u32x2){0u, 0u}; mmn[j] = (u32x2){0u, 0u}; mmn2[j] = (u32x2){0u, 0u};
    vn[j] = (float4){0.f, 0.f, 0.f, 0.f}; vn2[j] = (float4){0.f, 0.f, 0.f, 0.f};
  }
  load_row(r0, v, mm);
  if (r0 + 1 < r1) load_row(r0 + 1, vn, mmn);
  for (int row = r0; row < r1; ++row) {
    if (row + 2 < r1) load_row(row + 2, vn2, mmn2);
    int bb, tokbase, S;
    seq_of_token(row, bb, tokbase, S);
    if (bb != cur_bb) {
      cur_bb = bb;
      const float* mrow = mod + (layer * 10 + bb) * 6144 + sub * 3072;
      const float* grow = mod + (glayer * 10 + bb) * 6144 + goff;
#pragma unroll
      for (int j = 0; j < 4; ++j) {
        const int c = j * 256 + lane * 4;
        const float4 g = *(const float4*)(gn + c);
        if (final_) { pg[j] = g; psh[j] = (float4){0.f, 0.f, 0.f, 0.f}; }
        else {
          const float4 sh = *(const float4*)(mrow + c);
          const float4 sc = *(const float4*)(mrow + 1024 + c);
          pg[j] = (float4){g.x * (1.f + sc.x), g.y * (1.f + sc.y), g.z * (1.f + sc.z), g.w * (1.f + sc.w)};
          psh[j] = sh;
        }
        if (M) pgm[j] = *(const float4*)(grow + c);
      }
    }
    if (M) {
#pragma unroll
      for (int j = 0; j < 4; ++j) {
        const int c = j * 256 + lane * 4;
        v[j].x += pgm[j].x * __uint_as_float(mm[j].x << 16);
        v[j].y += pgm[j].y * __uint_as_float(mm[j].x & 0xffff0000u);
        v[j].z += pgm[j].z * __uint_as_float(mm[j].y << 16);
        v[j].w += pgm[j].w * __uint_as_float(mm[j].y & 0xffff0000u);
        if (!final_) *(float4*)(p.out + (size_t)row * DM + c) = v[j];
      }
    }
    float ss = 0.f;
#pragma unroll
    for (int j = 0; j < 4; ++j) ss += v[j].x * v[j].x + v[j].y * v[j].y + v[j].z * v[j].z + v[j].w * v[j].w;
#pragma unroll
    for (int o = 1; o < 64; o <<= 1) ss += __shfl_xor(ss, o);
    const float rstd = rsqrtf(ss * (1.f / 1024.f) + 1e-6f);
    if (final_) {
#pragma unroll
      for (int j = 0; j < 4; ++j) {
        float4 o4 = {v[j].x * rstd * pg[j].x, v[j].y * rstd * pg[j].y, v[j].z * rstd * pg[j].z, v[j].w * rstd * pg[j].w};
        *(float4*)(p.out + (size_t)row * DM + j * 256 + lane * 4) = o4;
      }
    } else {
#pragma unroll
      for (int j = 0; j < 4; ++j) {
        const int c = j * 256 + lane * 4;
        const float a0 = v[j].x * rstd * pg[j].x + psh[j].x;
        const float a1 = v[j].y * rstd * pg[j].y + psh[j].y;
        const float a2 = v[j].z * rstd * pg[j].z + psh[j].z;
        const float a3 = v[j].w * rstd * pg[j].w + psh[j].w;
        u32x2 o2 = {pk_bf16(a0, a1), pk_bf16(a2, a3)};
        *(u32x2*)(H + (size_t)row * DM + c) = o2;
      }
    }
#pragma unroll
    for (int j = 0; j < 4; ++j) { v[j] = vn[j]; mm[j] = mmn[j]; vn[j] = vn2[j]; mmn[j] = mmn2[j]; }
  }
}

template <bool SWAP>
DI void gemm_mainloop(f32x16 (&acc)[4][2], const u16* __restrict__ A, int lda, int rlo, int rhi,
                      const u16* __restrict__ B, int ldb, int K, char* lds, const u16* zero_line) {
  const int tid = opaque_tid(), lane = tid & 63, w = tid >> 6;
  const int wm = w >> 2, wn = w & 3;
  const int h = lane >> 5, r = lane & 31;
  const int lr = tid >> 3, lc = tid & 7;
#pragma unroll
  for (int mi = 0; mi < 4; ++mi)
#pragma unroll
    for (int ni = 0; ni < 2; ++ni)
#pragma unroll
      for (int i = 0; i < 16; ++i) acc[mi][ni][i] = 0.f;
  const int gch = (lc ^ ((lr >> 1) & 7)) * 8;
  const u16* ap = A + (ptrdiff_t)lr * lda + gch;
  const u16* bp = B + (ptrdiff_t)lr * ldb + gch;
  const int nk = K >> 6;
  typedef __attribute__((address_space(3))) unsigned lds_u32;
  auto glds = [&](int kt, int st) {
    char* as_ = lds + st * 65536 + tid * 16;
#pragma unroll
    for (int i = 0; i < 4; ++i) {
      const int rr = lr + 64 * i;
      const u16* srca = (rr >= rlo && rr < rhi) ? (ap + (ptrdiff_t)(64 * i) * lda + kt * 64) : (zero_line + lc * 8);
      __builtin_amdgcn_global_load_lds((const unsigned*)srca, (lds_u32*)(as_ + i * 8192), 16, 0, 0);
      __builtin_amdgcn_global_load_lds((const unsigned*)(bp + (ptrdiff_t)(64 * i) * ldb + kt * 64), (lds_u32*)(as_ + 32768 + i * 8192), 16, 0, 0);
    }
  };
  const int sw = (r >> 1) & 7;
  const int arow_off = (wm * 128 + r) * 128;
  const int brow_off = 32768 + (wn * 64 + r) * 128;
  __syncthreads();
  glds(0, 0);
  asm volatile("s_waitcnt vmcnt(0)" ::: "memory");
  __syncthreads();
  bf16x8 fa[2][4], fb[2][2];
#pragma unroll
  for (int mi = 0; mi < 4; ++mi)
#pragma unroll
    for (int e = 0; e < 8; ++e) fa[1][mi][e] = 0;
#pragma unroll
  for (int ni = 0; ni < 2; ++ni)
#pragma unroll
    for (int e = 0; e < 8; ++e) fb[1][ni][e] = 0;
  auto ldfrag = [&](const char* st, int ks, int buf) {
    const int co = ((2 * ks + h) ^ sw) << 4;
#pragma unroll
    for (int mi = 0; mi < 4; ++mi) fa[buf][mi] = *(const bf16x8*)(st + arow_off + mi * 4096 + co);
#pragma unroll
    for (int ni = 0; ni < 2; ++ni) fb[buf][ni] = *(const bf16x8*)(st + brow_off + ni * 4096 + co);
  };
  auto mma = [&](int buf) {
#pragma unroll
    for (int mi = 0; mi < 4; ++mi)
#pragma unroll
      for (int ni = 0; ni < 2; ++ni)
        acc[mi][ni] = SWAP ? MFMA(fb[buf][ni], fa[buf][mi], acc[mi][ni]) : MFMA(fa[buf][mi], fb[buf][ni], acc[mi][ni]);
  };
  auto pat_rd = [&]() {
#pragma unroll
    for (int g = 0; g < 6; ++g) {
      __builtin_amdgcn_sched_group_barrier(0x100, 1, 0);
      __builtin_amdgcn_sched_group_barrier(0x008, 1, 0);
    }
    __builtin_amdgcn_sched_group_barrier(0x008, 2, 0);
  };
  for (int kt = 0; kt < nk; ++kt) {
    const char* st = lds + (kt & 1) * 65536;
    ldfrag(st, 0, 0);
    mma(1);
    pat_rd();
    if (kt + 1 < nk) glds(kt + 1, (kt + 1) & 1);
    ldfrag(st, 1, 1);
    mma(0);
    pat_rd();
    ldfrag(st, 2, 0);
    mma(1);
    pat_rd();
    ldfrag(st, 3, 1);
    mma(0);
    pat_rd();
    asm volatile("s_waitcnt vmcnt(0)" ::: "memory");
    __syncthreads();
  }
  mma(1);
}

DI void tile_mn(int t, int Mt, int Nt, int& m, int& n) {
  const int per = 8 * Nt;
  int g = t / per;
  int rem = t - g * per;
  int gs = Mt - g * 8;
  if (gs > 8) gs = 8;
  n = rem / gs;
  m = g * 8 + (rem - n * gs);
}

enum { EPI_INPROJ = 0, EPI_M = 1, EPI_UP = 2, EPI_QKV1 = 3 };

struct GemmArgs {
  const u16* A; int lda; const u16* Bt; int K; int Nt; int layer; u16* Mout;
};

template <int EPI>
DI void phase_gemm(const Params& p, const GemmArgs& ga, char* lds) {
  const int tid = opaque_tid(), lane = tid & 63, w = tid >> 6;
  const int wm = w >> 2, wn = w & 3;
  const int h = lane >> 5, r = lane & 31;
  const int Mt = (EPI == EPI_UP) ? 194 : 192;
  const int total = Mt * ga.Nt;
  for (int it = 0; it * (int)gridDim.x < total; ++it) {
    const int lt = logical_index(it);
    if (lt >= total) continue;
    int mt, nt;
    tile_mn(lt, Mt, ga.Nt, mt, nt);
    int bb, tokbase, S, pos0, rlo = 0, rhi = 256;
    if (EPI == EPI_UP) {
      bb = 0; tokbase = 0; S = NTOK;
      pos0 = 254 * mt - 1;
      rlo = (mt == 0) ? 1 : 0;
      rhi = NTOK - pos0; if (rhi > 256) rhi = 256;
    } else {
      seq_of_token(mt * 256, bb, tokbase, S);
      pos0 = mt * 256 - tokbase;
    }
    const u16* A = ga.A + (ptrdiff_t)(tokbase + pos0) * ga.lda;
    const u16* B = ga.Bt + (size_t)(nt * 256) * ga.K;
    f32x16 acc[4][2];
    bool swap;
    if (EPI == EPI_M) swap = true;
    else if (EPI == EPI_UP) swap = true;
    else if (EPI == EPI_QKV1) swap = (nt < 8);
    else swap = !(nt == 4 || nt == 5);
    if (swap) gemm_mainloop<true>(acc, A, ga.lda, rlo, rhi, B, ga.K, ga.K, lds, (const u16*)(p.ws + OFF_ZERO));
    else gemm_mainloop<false>(acc, A, ga.lda, rlo, rhi, B, ga.K, ga.K, lds, (const u16*)(p.ws + OFF_ZERO));

    const int n0w = nt * 256 + wn * 64;
    if (EPI == EPI_M) {
      u16* mo = ga.Mout + (size_t)(tokbase + pos0 + wm * 128 + r) * DM + n0w + 8 * h;
#pragma unroll
      for (int mi = 0; mi < 4; ++mi)
#pragma unroll
        for (int ni = 0; ni < 2; ++ni)
#pragma unroll
          for (int jp = 0; jp < 2; ++jp) {
            u32x2 X = {pk_bf16(acc[mi][ni][8 * jp], acc[mi][ni][8 * jp + 1]), pk_bf16(acc[mi][ni][8 * jp + 2], acc[mi][ni][8 * jp + 3])};
            u32x2 Y = {pk_bf16(acc[mi][ni][8 * jp + 4], acc[mi][ni][8 * jp + 5]), pk_bf16(acc[mi][ni][8 * jp + 6], acc[mi][ni][8 * jp + 7])};
            half_swap(X, Y);
            u32x4 v = {X.x, X.y, Y.x, Y.y};
            *(u32x4*)(mo + (size_t)(mi * 32) * DM + ni * 32 + 16 * jp) = v;
          }
    } else if (EPI == EPI_QKV1) {
      u16* QK = (u16*)(p.ws + OFF_BIG);
      u16* VT = (u16*)(p.ws + OFF_VT1);
      if (swap) {
        const float sc = (n0w < 1024) ? QK_SCALE_LOG2 : 1.f;
        u16* qo = QK + (size_t)(tokbase + pos0 + wm * 128 + r) * QK1_LD + n0w + 8 * h;
#pragma unroll
        for (int mi = 0; mi < 4; ++mi)
#pragma unroll
          for (int ni = 0; ni < 2; ++ni)
#pragma unroll
            for (int jp = 0; jp < 2; ++jp) {
              u32x2 X = {pk_bf16(acc[mi][ni][8 * jp] * sc, acc[mi][ni][8 * jp + 1] * sc), pk_bf16(acc[mi][ni][8 * jp + 2] * sc, acc[mi][ni][8 * jp + 3] * sc)};
              u32x2 Y = {pk_bf16(acc[mi][ni][8 * jp + 4] * sc, acc[mi][ni][8 * jp + 5] * sc), pk_bf16(acc[mi][ni][8 * jp + 6] * sc, acc[mi][ni][8 * jp + 7] * sc)};
              half_swap(X, Y);
              u32x4 v = {X.x, X.y, Y.x, Y.y};
              *(u32x4*)(qo + (size_t)(mi * 32) * QK1_LD + ni * 32 + 16 * jp) = v;
            }
      } else {
#pragma unroll
        for (int ni = 0; ni < 2; ++ni) {
          const int vrow = n0w - 2048 + ni * 32 + r;
          u16* vb = VT + (size_t)1024 * tokbase + (size_t)vrow * S;
#pragma unroll
          for (int mi = 0; mi < 4; ++mi)
#pragma unroll
            for (int jp = 0; jp < 2; ++jp) {
              const int pos = pos0 + wm * 128 + mi * 32 + 16 * jp + 8 * h;
              u32x2 X = {pk_bf16(acc[mi][ni][8 * jp], acc[mi][ni][8 * jp + 1]), pk_bf16(acc[mi][ni][8 * jp + 2], acc[mi][ni][8 * jp + 3])};
              u32x2 Y = {pk_bf16(acc[mi][ni][8 * jp + 4], acc[mi][ni][8 * jp + 5]), pk_bf16(acc[mi][ni][8 * jp + 6], acc[mi][ni][8 * jp + 7])};
              half_swap(X, Y);
              u32x4 v = {X.x, X.y, Y.x, Y.y};
              *(u32x4*)(vb + pos) = v;
            }
        }
      }
    } else if (EPI == EPI_INPROJ) {
      u16* QK = (u16*)(p.ws + OFF_BIG);
      u16* VT = (u16*)(p.ws + OFF_VT0);
      if (!swap) {
#pragma unroll
        for (int ni = 0; ni < 2; ++ni) {
          const int vrow = (n0w - 1024) + ni * 32 + r;
          u16* vb = VT + (size_t)640 * tokbase + (size_t)vrow * S;
#pragma unroll
          for (int mi = 0; mi < 4; ++mi)
#pragma unroll
            for (int jp = 0; jp < 2; ++jp) {
              const int pos = pos0 + wm * 128 + mi * 32 + 16 * jp + 8 * h;
              u32x2 X = {pk_bf16(acc[mi][ni][8 * jp], acc[mi][ni][8 * jp + 1]), pk_bf16(acc[mi][ni][8 * jp + 2], acc[mi][ni][8 * jp + 3])};
              u32x2 Y = {pk_bf16(acc[mi][ni][8 * jp + 4], acc[mi][ni][8 * jp + 5]), pk_bf16(acc[mi][ni][8 * jp + 6], acc[mi][ni][8 * jp + 7])};
              half_swap(X, Y);
              u32x4 v = {X.x, X.y, Y.x, Y.y};
              *(u32x4*)(vb + pos) = v;
            }
        }
      } else if (n0w >= 2176) {
#pragma unroll
        for (int ni = 0; ni < 2; ++ni)
#pragma unroll
          for (int i = 0; i < 16; ++i) {
            const int vrow = 512 + (n0w - 2176) + ni * 32 + 8 * (i >> 2) + 4 * h + (i & 3);
            u16* vb = VT + (size_t)640 * tokbase + (size_t)vrow * S + pos0 + wm * 128 + r;
#pragma unroll
            for (int mi = 0; mi < 4; ++mi) vb[mi * 32] = to_bf16(acc[mi][ni][i]);
          }
      } else {
        const bool nrm = (n0w >= 1536);
        int dcol;
        const float* gq = p.gqa_qk_g;
        float osc = 1.f;
        if (n0w < 1024) { dcol = n0w; if (n0w < 512) osc = QK_SCALE_LOG2; }
        else if (n0w < 2048) { dcol = 1024 + (n0w - 1536); osc = QK_SCALE_LOG2; }
        else { dcol = 1536 + (n0w - 2048); gq += 64; }
        const float* cs = (const float*)(p.ws + (nrm ? OFF_CS2 : OFF_CS1));
#pragma unroll
        for (int mi = 0; mi < 4; ++mi) {
          const int pos = pos0 + wm * 128 + mi * 32 + r;
          float rs = 1.f;
          if (nrm) {
            float ss = 0.f;
#pragma unroll
            for (int i = 0; i < 16; ++i) ss += acc[mi][0][i] * acc[mi][0][i] + acc[mi][1][i] * acc[mi][1][i];
            ss += __shfl_xor(ss, 32);
            rs = rsqrtf(ss * (1.f / 64.f) + 1e-6f);
          }
          u16* q = QK + (size_t)(tokbase + pos) * QK0_LD + dcol + 8 * h;
          const float* csr = cs + (size_t)pos * 64 + 8 * h;
#pragma unroll
          for (int jp = 0; jp < 2; ++jp) {
            u32x2 v1[2], v2[2];
#pragma unroll
            for (int jj = 0; jj < 2; ++jj) {
              const int j = 2 * jp + jj;
              const float4 ca = *(const float4*)(csr + 16 * j);
              const float4 cb = *(const float4*)(csr + 16 * j + 4);
              float x1[4], x2[4];
#pragma unroll
              for (int e = 0; e < 4; ++e) { x1[e] = acc[mi][0][4 * j + e]; x2[e] = acc[mi][1][4 * j + e]; }
              if (nrm) {
                const float4 ga_ = *(const float4*)(gq + 8 * j + 4 * h);
                const float4 gb_ = *(const float4*)(gq + 32 + 8 * j + 4 * h);
                x1[0] *= rs * ga_.x; x1[1] *= rs * ga_.y; x1[2] *= rs * ga_.z; x1[3] *= rs * ga_.w;
                x2[0] *= rs * gb_.x; x2[1] *= rs * gb_.y; x2[2] *= rs * gb_.z; x2[3] *= rs * gb_.w;
              }
              const float cc[4] = {ca.x, ca.z, cb.x, cb.z};
              const float sn[4] = {ca.y, ca.w, cb.y, cb.w};
              float y1[4], y2[4];
#pragma unroll
              for (int e = 0; e < 4; ++e) {
                y1[e] = (x1[e] * cc[e] - x2[e] * sn[e]) * osc;
                y2[e] = (x2[e] * cc[e] + x1[e] * sn[e]) * osc;
              }
              v1[jj] = (u32x2){pk_bf16(y1[0], y1[1]), pk_bf16(y1[2], y1[3])};
              v2[jj] = (u32x2){pk_bf16(y2[0], y2[1]), pk_bf16(y2[2], y2[3])};
            }
            half_swap(v1[0], v1[1]);
            half_swap(v2[0], v2[1]);
            u32x4 w1 = {v1[0].x, v1[0].y, v1[1].x, v1[1].y};
            u32x4 w2 = {v2[0].x, v2[0].y, v2[1].x, v2[1].y};
            *(u32x4*)(q + 16 * jp) = w1;
            *(u32x4*)(q + 32 + 16 * jp) = w2;
          }
        }
      }
    } else {
      __syncthreads();
      constexpr int RS = 520;
      {
        char* wbase = lds + (wm * 128 + r) * RS + (wn * 64 + 4 * h) * 2;
#pragma unroll
        for (int mi = 0; mi < 4; ++mi)
#pragma unroll
          for (int ni = 0; ni < 2; ++ni)
#pragma unroll
            for (int j = 0; j < 4; ++j) {
              u32x2 v = {pk_bf16(acc[mi][ni][4 * j], acc[mi][ni][4 * j + 1]), pk_bf16(acc[mi][ni][4 * j + 2], acc[mi][ni][4 * j + 3])};
              *(u32x2*)(wbase + mi * 32 * RS + (ni * 32 + 8 * j) * 2) = v;
            }
      }
      __syncthreads();
      {
        const int q4 = tid & 31, seg = tid >> 5;
        const int ch = nt * 128 + 4 * q4;
        const float* cw = p.ffn_conv_w + (size_t)ga.layer * 3 * 5632;
        const float* cb = p.ffn_conv_b + (size_t)ga.layer * 5632;
        float4 wg[3], wv[3];
#pragma unroll
        for (int t3 = 0; t3 < 3; ++t3) { wg[t3] = *(const float4*)(cw + t3 * 5632 + ch); wv[t3] = *(const float4*)(cw + t3 * 5632 + DFF + ch); }
        const float4 bg = *(const float4*)(cb + ch);
        const float4 bv = *(const float4*)(cb + DFF + ch);
        const char* gbase = lds + q4 * 8;
        const char* vbase = lds + 256 + q4 * 8;
        const int R0 = 1 + seg * 16;
        const int Rend = (R0 + 16 < 255) ? (R0 + 16) : 255;
        auto ld4 = [&](const char* b_, int R) -> float4 {
          const u32x2 u = *(const u32x2*)(b_ + R * RS);
          float4 f = {__uint_as_float(u.x << 16), __uint_as_float(u.x & 0xffff0000u), __uint_as_float(u.y << 16), __uint_as_float(u.y & 0xffff0000u)};
          return f;
        };
        float4 pg = ld4(gbase, R0 - 1), pvv = ld4(vbase, R0 - 1);
        float4 cg_ = ld4(gbase, R0), cv_ = ld4(vbase, R0);
        u16* Aout = (u16*)(p.ws + OFF_BIG) + (ptrdiff_t)(tokbase + pos0) * DFF + ch;
#pragma unroll 4
        for (int R = R0; R < Rend; ++R) {
          const float4 ng = ld4(gbase, R + 1), nv = ld4(vbase, R + 1);
          if (pos0 + R < S) {
            const int tflat = pos0 + R;
            const int ps = (tflat < NTOK_P) ? (tflat & (SP - 1)) : ((tflat - NTOK_P) & (SS - 1));
            const int Ss = (tflat < NTOK_P) ? SP : SS;
            const float mp = (ps == 0) ? 0.f : 1.f;
            const float mn = (ps == Ss - 1) ? 0.f : 1.f;
            float g[4], v[4];
            g[0] = mp * pg.x * wg[0].x + cg_.x * wg[1].x + mn * ng.x * wg[2].x + bg.x;
            g[1] = mp * pg.y * wg[0].y + cg_.y * wg[1].y + mn * ng.y * wg[2].y + bg.y;
            g[2] = mp * pg.z * wg[0].z + cg_.z * wg[1].z + mn * ng.z * wg[2].z + bg.z;
            g[3] = mp * pg.w * wg[0].w + cg_.w * wg[1].w + mn * ng.w * wg[2].w + bg.w;
            v[0] = mp * pvv.x * wv[0].x + cv_.x * wv[1].x + mn * nv.x * wv[2].x + bv.x;
            v[1] = mp * pvv.y * wv[0].y + cv_.y * wv[1].y + mn * nv.y * wv[2].y + bv.y;
            v[2] = mp * pvv.z * wv[0].z + cv_.z * wv[1].z + mn * nv.z * wv[2].z + bv.z;
            v[3] = mp * pvv.w * wv[0].w + cv_.w * wv[1].w + mn * nv.w * wv[2].w + bv.w;
            float a_[4];
#pragma unroll
            for (int e = 0; e < 4; ++e) a_[e] = g[e] * __builtin_amdgcn_rcpf(1.f + fexp2(-1.4426950408889634f * g[e])) * v[e];
            u32x2 ov = {pk_bf16(a_[0], a_[1]), pk_bf16(a_[2], a_[3])};
            *(u32x2*)(Aout + (ptrdiff_t)R * DFF) = ov;
          }
          pg = cg_; pvv = cv_; cg_ = ng; cv_ = nv;
        }
      }
    }
  }
}

constexpr int ATT_STAGE = 24576;
template <int DV, bool NA>
DI void flash_pass(f32x16 (&o)[DV / 32], const u16* __restrict__ Qp, const u16* __restrict__ Kb, int ldk,
                   const u16* __restrict__ Vt, int S, int tile0, int ntiles, char* lds, float cscale,
                   int wlo, int whi, const float* bias_lds, int r_w, int qc) {
  const int tid = opaque_tid(), lane = tid & 63;
  const int h = lane >> 5, r = lane & 31;
  bf16x8 q[4];
#pragma unroll
  for (int ks = 0; ks < 4; ++ks) q[ks] = *(const bf16x8*)(Qp + ks * 16 + h * 8);
#pragma unroll
  for (int mv = 0; mv < DV / 32; ++mv)
#pragma unroll
    for (int i = 0; i < 16; ++i) o[mv][i] = 0.f;
  float m_run = -INFINITY, l_run = 0.f;
  const int lr = tid >> 3, lc = tid & 7;
  const int wsw = lr * 128 + ((lc ^ ((lr >> 1) & 7)) << 4);
  u32x4 rk, rv[DV / 64];
  auto gload = [&](int ti) {
    const size_t key0 = (size_t)(tile0 + ti) * 64;
    rk = *(const u32x4*)(Kb + (key0 + lr) * ldk + lc * 8);
#pragma unroll
    for (int i = 0; i < DV / 64; ++i) rv[i] = *(const u32x4*)(Vt + (size_t)(lr + 64 * i) * S + key0 + lc * 8);
  };
  auto swrite = [&](int st) {
    char* ks_ = lds + st * ATT_STAGE;
    *(u32x4*)(ks_ + wsw) = rk;
#pragma unroll
    for (int i = 0; i < DV / 64; ++i) *(u32x4*)(ks_ + 8192 + i * 8192 + wsw) = rv[i];
  };
  const int pr = (r & 0x13) | ((r & 4) << 1) | ((r & 8) >> 1);
  const int ksw = (pr >> 1) & 7;
  const int vsw = (r >> 1) & 7;
  const int cs_ = NA ? min(max(qc - 8, 0), 48) : 0;
  __syncthreads();
  gload(0);
  swrite(0);
  if (ntiles > 1) gload(1);
  __syncthreads();
  for (int ti = 0; ti < ntiles; ++ti) {
    if (ti + 1 < ntiles) {
      swrite((ti + 1) & 1);
      if (ti + 2 < ntiles) gload(ti + 2);
    }
    const char* st = lds + (ti & 1) * ATT_STAGE;
    const bool active = !NA || ((tile0 + ti) >= wlo && (tile0 + ti) <= whi);
    if (active) {
      f32x16 s0, s1;
#pragma unroll
      for (int i = 0; i < 16; ++i) { s0[i] = 0.f; s1[i] = 0.f; }
      {
        bf16x8 ka[4], kb_[4];
#pragma unroll
        for (int ks = 0; ks < 4; ++ks) {
          const int co = ((2 * ks + h) ^ ksw) << 4;
          ka[ks] = *(const bf16x8*)(st + pr * 128 + co);
          kb_[ks] = *(const bf16x8*)(st + (32 + pr) * 128 + co);
        }
        asm volatile("" ::: "memory");
#pragma unroll
        for (int ks = 0; ks < 4; ++ks) {
          s0 = MFMA(ka[ks], q[ks], s0);
          s1 = MFMA(kb_[ks], q[ks], s1);
        }
      }
      bf16x8 vf0[2][DV / 32];
#pragma unroll
      for (int c2 = 0; c2 < 2; ++c2) {
        const int co = ((2 * c2 + h) ^ vsw) << 4;
#pragma unroll
        for (int mv = 0; mv < DV / 32; ++mv) vf0[c2][mv] = *(const bf16x8*)(st + 8192 + (mv * 32 + r) * 128 + co);
      }
      asm volatile("" ::: "memory");
      float t[32];
#pragma unroll
      for (int i = 0; i < 16; ++i) { t[i] = s0[i]; t[16 + i] = s1[i]; }
      if (NA) {
        const int kr = tile0 + ti;
        const int brow = (kr - r_w + 7) * 31;
#pragma unroll
        for (int e = 0; e < 32; ++e) {
          const int i = e & 15, j = i >> 2;
          const int kc = (e >> 4) * 32 + 16 * (j >> 1) + 8 * h + 4 * (j & 1) + (i & 3);
          const bool valid = (kc >= cs_) && (kc < cs_ + 16);
          const int bi = valid ? (brow + kc - qc + 15) : 0;
          const float bv = bias_lds[bi];
          t[e] = valid ? (t[e] + bv) : -INFINITY;
        }
      }
      float mx = t[0];
#pragma unroll
      for (int e = 1; e < 32; ++e) mx = fmaxf(mx, t[e]);
      mx = fmaxf(mx, __shfl_xor(mx, 32));
      if (__builtin_amdgcn_ballot_w64(mx > m_run + 8.f) != 0ull) {
        const float m_new = fmaxf(m_run, mx);
        const float alpha = fexp2(m_run - m_new);
        l_run *= alpha;
        m_run = m_new;
#pragma unroll
        for (int mv = 0; mv < DV / 32; ++mv)
#pragma unroll
          for (int i = 0; i < 16; ++i) o[mv][i] *= alpha;
      }
      float ls = 0.f;
#pragma unroll
      for (int e = 0; e < 32; ++e) { t[e] = fexp2(t[e] - m_run); ls += t[e]; }
      l_run += ls;
      bf16x8 pf[2][2];
#pragma unroll
      for (int kb = 0; kb < 2; ++kb)
#pragma unroll
        for (int c2 = 0; c2 < 2; ++c2) {
          const int e0 = kb * 16 + c2 * 8;
          u32x4 pw = {pk_bf16(t[e0], t[e0 + 1]), pk_bf16(t[e0 + 2], t[e0 + 3]), pk_bf16(t[e0 + 4], t[e0 + 5]), pk_bf16(t[e0 + 6], t[e0 + 7])};
          pf[kb][c2] = __builtin_bit_cast(bf16x8, pw);
        }
      bf16x8 vf1[2][DV / 32];
#pragma unroll
      for (int c2 = 0; c2 < 2; ++c2) {
        const int co = ((4 + 2 * c2 + h) ^ vsw) << 4;
#pragma unroll
        for (int mv = 0; mv < DV / 32; ++mv) vf1[c2][mv] = *(const bf16x8*)(st + 8192 + (mv * 32 + r) * 128 + co);
      }
      asm volatile("" ::: "memory");
#pragma unroll
      for (int c2 = 0; c2 < 2; ++c2)
#pragma unroll
        for (int mv = 0; mv < DV / 32; ++mv) o[mv] = MFMA(vf0[c2][mv], pf[0][c2], o[mv]);
#pragma unroll
      for (int c2 = 0; c2 < 2; ++c2)
#pragma unroll
        for (int mv = 0; mv < DV / 32; ++mv) o[mv] = MFMA(vf1[c2][mv], pf[1][c2], o[mv]);
    }
    __syncthreads();
  }
  const float lt = l_run + __shfl_xor(l_run, 32);
  const float inv = 1.f / lt;
#pragma unroll
  for (int mv = 0; mv < DV / 32; ++mv)
#pragma unroll
    for (int i = 0; i < 16; ++i) o[mv][i] *= inv;
}


DI void flash_pass_q2(f32x16 (&o)[2][2], const u16* __restrict__ Qp0, const u16* __restrict__ Qp1,
                      const u16* __restrict__ Kb, int ldk, const u16* __restrict__ Vt, int S, int ntiles, char* lds) {
  const int tid = opaque_tid(), lane = tid & 63;
  const int h = lane >> 5, r = lane & 31;
  bf16x8 q[2][4];
#pragma unroll
  for (int ks = 0; ks < 4; ++ks) {
    q[0][ks] = *(const bf16x8*)(Qp0 + ks * 16 + h * 8);
    q[1][ks] = *(const bf16x8*)(Qp1 + ks * 16 + h * 8);
  }
#pragma unroll
  for (int hq = 0; hq < 2; ++hq)
#pragma unroll
    for (int mv = 0; mv < 2; ++mv)
#pragma unroll
      for (int i = 0; i < 16; ++i) o[hq][mv][i] = 0.f;
  float m_run[2] = {-INFINITY, -INFINITY}, l_run[2] = {0.f, 0.f};
  const int lr = tid >> 3, lc = tid & 7;
  const int wsw = lr * 128 + ((lc ^ ((lr >> 1) & 7)) << 4);
  u32x4 rk, rv;
  auto gload = [&](int ti) {
    const size_t key0 = (size_t)ti * 64;
    rk = *(const u32x4*)(Kb + (key0 + lr) * ldk + lc * 8);
    rv = *(const u32x4*)(Vt + (size_t)lr * S + key0 + lc * 8);
  };
  auto swrite = [&](int st) {
    char* ks_ = lds + st * ATT_STAGE;
    *(u32x4*)(ks_ + wsw) = rk;
    *(u32x4*)(ks_ + 8192 + wsw) = rv;
  };
  const int pr = (r & 0x13) | ((r & 4) << 1) | ((r & 8) >> 1);
  const int ksw = (pr >> 1) & 7;
  const int vsw = (r >> 1) & 7;
  __syncthreads();
  gload(0);
  swrite(0);
  if (ntiles > 1) gload(1);
  __syncthreads();
  for (int ti = 0; ti < ntiles; ++ti) {
    if (ti + 1 < ntiles) {
      swrite((ti + 1) & 1);
      if (ti + 2 < ntiles) gload(ti + 2);
    }
    const char* st = lds + (ti & 1) * ATT_STAGE;
    f32x16 s[2][2];
#pragma unroll
    for (int hq = 0; hq < 2; ++hq)
#pragma unroll
      for (int kb = 0; kb < 2; ++kb)
#pragma unroll
        for (int i = 0; i < 16; ++i) s[hq][kb][i] = 0.f;
    {
      bf16x8 ka[4], kb_[4];
#pragma unroll
      for (int ks = 0; ks < 4; ++ks) {
        const int co = ((2 * ks + h) ^ ksw) << 4;
        ka[ks] = *(const bf16x8*)(st + pr * 128 + co);
        kb_[ks] = *(const bf16x8*)(st + (32 + pr) * 128 + co);
      }
      asm volatile("" ::: "memory");
#pragma unroll
      for (int ks = 0; ks < 4; ++ks) {
        s[0][0] = MFMA(ka[ks], q[0][ks], s[0][0]);
        s[0][1] = MFMA(kb_[ks], q[0][ks], s[0][1]);
        s[1][0] = MFMA(ka[ks], q[1][ks], s[1][0]);
        s[1][1] = MFMA(kb_[ks], q[1][ks], s[1][1]);
      }
    }
    bf16x8 pf[2][2][2];
#pragma unroll
    for (int hq = 0; hq < 2; ++hq) {
      float t[32];
#pragma unroll
      for (int i = 0; i < 16; ++i) { t[i] = s[hq][0][i]; t[16 + i] = s[hq][1][i]; }
      float mx = t[0];
#pragma unroll
      for (int e = 1; e < 32; ++e) mx = fmaxf(mx, t[e]);
      mx = fmaxf(mx, __shfl_xor(mx, 32));
      if (__builtin_amdgcn_ballot_w64(mx > m_run[hq] + 8.f) != 0ull) {
        const float m_new = fmaxf(m_run[hq], mx);
        const float alpha = fexp2(m_run[hq] - m_new);
        l_run[hq] *= alpha;
        m_run[hq] = m_new;
#pragma unroll
        for (int mv = 0; mv < 2; ++mv)
#pragma unroll
          for (int i = 0; i < 16; ++i) o[hq][mv][i] *= alpha;
      }
      float ls = 0.f;
#pragma unroll
      for (int e = 0; e < 32; ++e) { t[e] = fexp2(t[e] - m_run[hq]); ls += t[e]; }
      l_run[hq] += ls;
#pragma unroll
      for (int kb = 0; kb < 2; ++kb)
#pragma unroll
        for (int c2 = 0; c2 < 2; ++c2) {
          const int e0 = kb * 16 + c2 * 8;
          u32x4 pw = {pk_bf16(t[e0], t[e0 + 1]), pk_bf16(t[e0 + 2], t[e0 + 3]), pk_bf16(t[e0 + 4], t[e0 + 5]), pk_bf16(t[e0 + 6], t[e0 + 7])};
          pf[hq][kb][c2] = __builtin_bit_cast(bf16x8, pw);
        }
    }
    bf16x8 vf[2][2][2];
#pragma unroll
    for (int kb = 0; kb < 2; ++kb)
#pragma unroll
      for (int c2 = 0; c2 < 2; ++c2) {
        const int co = ((4 * kb + 2 * c2 + h) ^ vsw) << 4;
#pragma unroll
        for (int mv = 0; mv < 2; ++mv) vf[kb][c2][mv] = *(const bf16x8*)(st + 8192 + (mv * 32 + r) * 128 + co);
      }
    asm volatile("" ::: "memory");
#pragma unroll
    for (int kb = 0; kb < 2; ++kb)
#pragma unroll
      for (int c2 = 0; c2 < 2; ++c2)
#pragma unroll
        for (int mv = 0; mv < 2; ++mv) {
          o[0][mv] = MFMA(vf[kb][c2][mv], pf[0][kb][c2], o[0][mv]);
          o[1][mv] = MFMA(vf[kb][c2][mv], pf[1][kb][c2], o[1][mv]);
        }
    __syncthreads();
  }
#pragma unroll
  for (int hq = 0; hq < 2; ++hq) {
    const float lt = l_run[hq] + __shfl_xor(l_run[hq], 32);
    const float inv = 1.f / lt;
#pragma unroll
    for (int mv = 0; mv < 2; ++mv)
#pragma unroll
      for (int i = 0; i < 16; ++i) o[hq][mv][i] *= inv;
  }
}

DI void flash_pass_na(f32x16 (&o)[2], const u16* __restrict__ Qp, const u16* __restrict__ Kb, int ldk,
                      const u16* __restrict__ Vt, int S, int tile0, int ntiles, char* lds, int wlo, int whi,
                      const float* bias_lds, int qrow, int rs_q, int qcol, int cs0, int hsel) {
  const int tid = opaque_tid(), lane = tid & 63;
  const int h = lane >> 5, r = lane & 31;
  bf16x8 q[4];
#pragma unroll
  for (int ks = 0; ks < 4; ++ks) q[ks] = *(const bf16x8*)(Qp + ks * 16 + h * 8);
#pragma unroll
  for (int mv = 0; mv < 2; ++mv)
#pragma unroll
    for (int i = 0; i < 16; ++i) o[mv][i] = 0.f;
  float m_run = -1e30f, l_run = 0.f;
  const int lr = tid >> 3, lc = tid & 7;
  const int wsw = lr * 128 + ((lc ^ ((lr >> 1) & 7)) << 4);
  constexpr int NA_STAGE = 32768;
  u32x4 rk[2], rv[2];
  auto gload = [&](int ti) {
    const size_t key0 = (size_t)(tile0 + ti) * 64;
#pragma unroll
    for (int hh = 0; hh < 2; ++hh) {
      rk[hh] = *(const u32x4*)(Kb + (key0 + lr) * ldk + hh * 64 + lc * 8);
      rv[hh] = *(const u32x4*)(Vt + (size_t)(hh * 64 + lr) * S + key0 + lc * 8);
    }
  };
  auto swrite = [&](int st) {
    char* ks_ = lds + st * NA_STAGE;
#pragma unroll
    for (int hh = 0; hh < 2; ++hh) {
      *(u32x4*)(ks_ + hh * 16384 + wsw) = rk[hh];
      *(u32x4*)(ks_ + hh * 16384 + 8192 + wsw) = rv[hh];
    }
  };
  const int pr = (r & 0x13) | ((r & 4) << 1) | ((r & 8) >> 1);
  const int krow = cs0 + pr;
  const int ksw = (krow >> 1) & 7;
  const int vsw = (r >> 1) & 7;
  const int vch0 = cs0 >> 3;
  const int csq = min(max(qcol - 8, 0), 48);
  bool navalid[16];
#pragma unroll
  for (int i = 0; i < 16; ++i) {
    const int j = i >> 2;
    const int kc = cs0 + 16 * (j >> 1) + 8 * h + 4 * (j & 1) + (i & 3);
    navalid[i] = (unsigned)(kc - csq) < 16u;
  }
  const int dcb = cs0 + 8 * h - qcol + 15;
  __syncthreads();
  gload(0);
  swrite(0);
  if (ntiles > 1) gload(1);
  __syncthreads();
  for (int ti = 0; ti < ntiles; ++ti) {
    if (ti + 1 < ntiles) {
      swrite((ti + 1) & 1);
      if (ti + 2 < ntiles) gload(ti + 2);
    }
    const char* st = lds + (ti & 1) * NA_STAGE + hsel * 16384;
    const int kr = tile0 + ti;
    if (kr >= wlo && kr <= whi) {
      f32x16 s0;
#pragma unroll
      for (int i = 0; i < 16; ++i) s0[i] = 0.f;
      {
        bf16x8 ka[4];
#pragma unroll
        for (int ks = 0; ks < 4; ++ks) ka[ks] = *(const bf16x8*)(st + krow * 128 + (((2 * ks + h) ^ ksw) << 4));
        asm volatile("" ::: "memory");
#pragma unroll
        for (int ks = 0; ks < 4; ++ks) s0 = MFMA(ka[ks], q[ks], s0);
      }
      bf16x8 vf[2][2];
#pragma unroll
      for (int c2 = 0; c2 < 2; ++c2) {
        const int co = ((vch0 + 2 * c2 + h) ^ vsw) << 4;
#pragma unroll
        for (int mv = 0; mv < 2; ++mv) vf[c2][mv] = *(const bf16x8*)(st + 8192 + (mv * 32 + r) * 128 + co);
      }
      asm volatile("" ::: "memory");
      const bool rowok = (kr >= rs_q) && (kr <= rs_q + 7);
      const int bidx = rowok ? ((kr - qrow + 7) * 31 + dcb) : 64;
      float t[16];
#pragma unroll
      for (int i = 0; i < 16; ++i) {
        const int j = i >> 2;
        const int kco = 16 * (j >> 1) + 4 * (j & 1) + (i & 3);
        const bool ok = navalid[i] && rowok;
        const float bv = bias_lds[ok ? (bidx + kco) : 0];
        t[i] = ok ? (s0[i] + bv) : -INFINITY;
      }
      float mx = t[0];
#pragma unroll
      for (int e = 1; e < 16; ++e) mx = fmaxf(mx, t[e]);
      mx = fmaxf(mx, __shfl_xor(mx, 32));
      if (__builtin_amdgcn_ballot_w64(mx > m_run + 8.f) != 0ull) {
        const float m_new = fmaxf(m_run, mx);
        const float alpha = fexp2(m_run - m_new);
        l_run *= alpha;
        m_run = m_new;
#pragma unroll
        for (int mv = 0; mv < 2; ++mv)
#pragma unroll
          for (int i = 0; i < 16; ++i) o[mv][i] *= alpha;
      }
      float ls = 0.f;
#pragma unroll
      for (int e = 0; e < 16; ++e) { t[e] = fexp2(t[e] - m_run); ls += t[e]; }
      l_run += ls;
#pragma unroll
      for (int c2 = 0; c2 < 2; ++c2) {
        const int e0 = c2 * 8;
        u32x4 pw = {pk_bf16(t[e0], t[e0 + 1]), pk_bf16(t[e0 + 2], t[e0 + 3]), pk_bf16(t[e0 + 4], t[e0 + 5]), pk_bf16(t[e0 + 6], t[e0 + 7])};
        const bf16x8 pf = __builtin_bit_cast(bf16x8, pw);
#pragma unroll
        for (int mv = 0; mv < 2; ++mv) o[mv] = MFMA(vf[c2][mv], pf, o[mv]);
      }
    }
    __syncthreads();
  }
  const float lt = l_run + __shfl_xor(l_run, 32);
  const float inv = 1.f / lt;
#pragma unroll
  for (int mv = 0; mv < 2; ++mv)
#pragma unroll
    for (int i = 0; i < 16; ++i) o[mv][i] *= inv;
}

DI void phase_attn0(const Params& p, char* lds) {
  const int tid = opaque_tid(), lane = tid & 63, w = tid >> 6;
  const int h = lane >> 5, r = lane & 31;
  const u16* QK = (const u16*)(p.ws + OFF_BIG);
  const u16* VT = (const u16*)(p.ws + OFF_VT0);
  u16* O = (u16*)(p.ws + OFF_H);
  float* stash = (float*)(p.ws + OFF_STASH) + (((size_t)blockIdx.x * 8 + w) * 64 + lane) * 64;
  float lam;
  {
    const float* lf = p.diff_lambda;
    float a = lf[lane] * lf[64 + lane];
    float b = lf[128 + lane] * lf[192 + lane];
#pragma unroll
    for (int o_ = 1; o_ < 64; o_ <<= 1) { a += __shfl_xor(a, o_); b += __shfl_xor(b, o_); }
    lam = __expf(a) - __expf(b) + 0.2f;
  }
  const int total = 1536;
  const int G = gridDim.x;
  const bool dyn = ((G & 7) == 0);
  unsigned* qhead = (unsigned*)(p.ws + OFF_BAR + 256 * (1 + (blockIdx.x & 7)));
  volatile int* qslot = (volatile int*)(lds + 2 * ATT_STAGE + 4096);
  for (int it0 = 0;; ++it0) {
    int lt;
    if (dyn) {
      __syncthreads();
      if (tid == 0) *qslot = (int)__hip_atomic_fetch_add(qhead, 1u, __ATOMIC_RELAXED, __HIP_MEMORY_SCOPE_AGENT);
      __syncthreads();
      const int k = *qslot;
      const int per = G >> 3;
      const int it = k / per;
      if (it * G >= total) break;
      lt = it * G + (blockIdx.x & 7) * per + (k - it * per);
    } else {
      if (it0 * G >= total) break;
      lt = it0 * G + blockIdx.x;
    }
    if (lt >= total) continue;
    int cls, bb, head, qb, S, tokbase;
    if (lt < 512) { cls = 0; bb = lt >> 8; head = (lt >> 6) & 3; qb = lt & 63; }
    else if (lt < 1024) { int u = lt - 512; cls = 1; bb = u >> 8; head = (u >> 6) & 3; qb = u & 63; }
    else if (lt < 1280) { int u = lt - 1024; cls = 0; bb = 2 + (u >> 5); head = (u >> 3) & 3; qb = u & 7; }
    else { int u = lt - 1280; cls = 1; bb = 2 + (u >> 5); head = (u >> 3) & 3; qb = u & 7; }
    if (bb < 2) { S = SP; tokbase = bb * SP; } else { S = SS; tokbase = NTOK_P + (bb - 2) * SS; }
    const int tq = tokbase + qb * 256 + w * 32 + r;
    const u16* Kseq = QK + (size_t)tokbase * QK0_LD;
    const u16* Vseq = VT + (size_t)640 * tokbase;
    if (cls == 0) {
      f32x16 o[4];
#pragma unroll 1
      for (int comp = 0; comp < 2; ++comp) {
        const int hc = head * 2 + comp;
        flash_pass<128, false>(o, QK + (size_t)tq * QK0_LD + hc * 64, Kseq + 512 + hc * 64, QK0_LD,
                               Vseq + (size_t)(head * 128) * S, S, 0, S >> 6, lds, QK_SCALE_LOG2, 0, 0, nullptr, 0, 0);
        if (comp == 0) {
#pragma unroll
          for (int mv = 0; mv < 4; ++mv) {
#pragma unroll
            for (int i = 0; i < 4; ++i) {
              float4 v4 = {o[mv][4 * i], o[mv][4 * i + 1], o[mv][4 * i + 2], o[mv][4 * i + 3]};
              *(float4*)(stash + mv * 16 + i * 4) = v4;
            }
            asm volatile("" ::: "memory");
          }
        }
      }
      float ss = 0.f;
#pragma unroll
      for (int mv = 0; mv < 4; ++mv) {
#pragma unroll
        for (int i = 0; i < 4; ++i) {
          const float4 s4 = *(const float4*)(stash + mv * 16 + i * 4);
          float v;
          v = s4.x - lam * o[mv][4 * i]; o[mv][4 * i] = v; ss += v * v;
          v = s4.y - lam * o[mv][4 * i + 1]; o[mv][4 * i + 1] = v; ss += v * v;
          v = s4.z - lam * o[mv][4 * i + 2]; o[mv][4 * i + 2] = v; ss += v * v;
          v = s4.w - lam * o[mv][4 * i + 3]; o[mv][4 * i + 3] = v; ss += v * v;
        }
        asm volatile("" ::: "memory");
      }
      ss += __shfl_xor(ss, 32);
      const float rs = rsqrtf(ss * (1.f / 128.f) + 1e-5f) * 0.8f;
      u16* orow = O + (size_t)tq * DM + head * 128;
#pragma unroll
      for (int mv = 0; mv < 4; ++mv) {
#pragma unroll
        for (int jp = 0; jp < 2; ++jp) {
          u32x2 XY[2];
#pragma unroll
          for (int jj = 0; jj < 2; ++jj) {
            const int j = 2 * jp + jj;
            const float4 g = *(const float4*)(p.diff_subln_g + mv * 32 + 8 * j + 4 * h);
            XY[jj] = (u32x2){pk_bf16(o[mv][4 * j] * rs * g.x, o[mv][4 * j + 1] * rs * g.y),
                             pk_bf16(o[mv][4 * j + 2] * rs * g.z, o[mv][4 * j + 3] * rs * g.w)};
          }
          half_swap(XY[0], XY[1]);
          u32x4 v = {XY[0].x, XY[0].y, XY[1].x, XY[1].y};
          *(u32x4*)(orow + mv * 32 + 16 * jp + 8 * h) = v;
        }
        asm volatile("" ::: "memory");
      }
    } else {
      f32x16 o[2][2];
      const int kvh = head >> 1;
      const u16* qrow = QK + (size_t)tq * QK0_LD + 1024 + (2 * head) * 64;
      flash_pass_q2(o, qrow, qrow + 64, Kseq + 1536 + kvh * 64, QK0_LD, Vseq + (size_t)(512 + kvh * 64) * S, S, S >> 6, lds);
#pragma unroll
      for (int hq = 0; hq < 2; ++hq) {
        u16* orow = O + (size_t)tq * DM + 512 + (2 * head + hq) * 64;
#pragma unroll
        for (int mv = 0; mv < 2; ++mv)
#pragma unroll
          for (int jp = 0; jp < 2; ++jp) {
            u32x2 X = {pk_bf16(o[hq][mv][8 * jp], o[hq][mv][8 * jp + 1]), pk_bf16(o[hq][mv][8 * jp + 2], o[hq][mv][8 * jp + 3])};
            u32x2 Y = {pk_bf16(o[hq][mv][8 * jp + 4], o[hq][mv][8 * jp + 5]), pk_bf16(o[hq][mv][8 * jp + 6], o[hq][mv][8 * jp + 7])};
            half_swap(X, Y);
            u32x4 v = {X.x, X.y, Y.x, Y.y};
            *(u32x4*)(orow + mv * 32 + 16 * jp + 8 * h) = v;
          }
      }
    }
  }
}

DI void phase_na(const Params& p, char* lds) {
  const int tid = opaque_tid(), lane = tid & 63, w = tid >> 6;
  const int h = lane >> 5, r = lane & 31;
  const u16* QK = (const u16*)(p.ws + OFF_BIG);
  const u16* VT = (const u16*)(p.ws + OFF_VT1);
  u16* O = (u16*)(p.ws + OFF_H);
  float* bias = (float*)(lds + 65536);
  const int total = 3072;
  for (int it = 0; it * (int)gridDim.x < total; ++it) {
    const int lt = logical_index(it);
    if (lt >= total) continue;
    int bb, hp, r2, S, tokbase, rows;
    if (lt < 2048) { bb = lt >> 10; hp = (lt >> 7) & 7; r2 = lt & 127; S = SP; tokbase = bb * SP; rows = 256; }
    else { int u = lt - 2048; bb = 2 + (u >> 7); hp = (u >> 4) & 7; r2 = u & 15; S = SS; tokbase = NTOK_P + (bb - 2) * SS; rows = 32; }
    __syncthreads();
    for (int e = tid; e < 930; e += NTHR) {
      const int hh = (e >= 465) ? 1 : 0;
      const int k = e - 465 * hh;
      bias[hh * 512 + k] = p.odd_rpb[(2 * hp + hh) * 465 + k] * 1.4426950408889634f;
    }
    const int rp0 = r2 * 2;
    const int wlo = min(max(rp0 - 4, 0), rows - 8);
    const int whi = min(max(rp0 + 1 - 4, 0), rows - 8) + 7;
    const int ntiles = whi - wlo + 1;
    const int hsel = w >> 2;
    const int head = 2 * hp + hsel;
    const int cq = w & 3;
    const int qrow = rp0 + (r >> 4);
    const int qcol = 16 * cq + (r & 15);
    const int rs_q = min(max(qrow - 4, 0), rows - 8);
    const int cs0 = min(max(16 * cq - 8, 0), 32);
    const int tq = tokbase + qrow * 64 + qcol;
    f32x16 o[2];
    flash_pass_na(o, QK + (size_t)tq * QK1_LD + head * 64, QK + (size_t)tokbase * QK1_LD + 1024 + (2 * hp) * 64, QK1_LD,
                  VT + (size_t)1024 * tokbase + (size_t)((2 * hp) * 64) * S, S, wlo, ntiles, lds,
                  wlo, whi, bias + hsel * 512, qrow, rs_q, qcol, cs0, hsel);
    u16* orow = O + (size_t)tq * DM + head * 64;
#pragma unroll
    for (int mv = 0; mv < 2; ++mv)
#pragma unroll
      for (int jp = 0; jp < 2; ++jp) {
        u32x2 X = {pk_bf16(o[mv][8 * jp], o[mv][8 * jp + 1]), pk_bf16(o[mv][8 * jp + 2], o[mv][8 * jp + 3])};
        u32x2 Y = {pk_bf16(o[mv][8 * jp + 4], o[mv][8 * jp + 5]), pk_bf16(o[mv][8 * jp + 6], o[mv][8 * jp + 7])};
        half_swap(X, Y);
        u32x4 v = {X.x, X.y, Y.x, Y.y};
        *(u32x4*)(orow + mv * 32 + 16 * jp + 8 * h) = v;
      }
  }
}

DI void grid_barrier(unsigned* ctr, unsigned target) {
  asm volatile("s_waitcnt vmcnt(0)" ::: "memory");
  __syncthreads();
  if (threadIdx.x == 0) {
    __builtin_amdgcn_fence(__ATOMIC_RELEASE, "agent");
    asm volatile("s_waitcnt vmcnt(0)" ::: "memory");
    __hip_atomic_fetch_add(ctr, 1u, __ATOMIC_RELAXED, __HIP_MEMORY_SCOPE_AGENT);
    while (__hip_atomic_load(ctr, __ATOMIC_RELAXED, __HIP_MEMORY_SCOPE_AGENT) < target) __builtin_amdgcn_s_sleep(1);
    __builtin_amdgcn_fence(__ATOMIC_ACQUIRE, "agent");
    asm volatile("s_waitcnt vmcnt(0)" ::: "memory");
  }
  __syncthreads();
}

__global__ void __launch_bounds__(NTHR) mega(Params p, int ph0, int ph1) {
  __shared__ __attribute__((aligned(16))) char lds[LDS_BYTES];
  unsigned* bar = (unsigned*)(p.ws + OFF_BAR);
  if (ph0 == 0 && blockIdx.x == 0 && threadIdx.x < 9)
    __hip_atomic_store((unsigned*)(p.ws + OFF_BAR + 256 * threadIdx.x), 0u, __ATOMIC_RELAXED, __HIP_MEMORY_SCOPE_AGENT);
  if (ph0 == 0 && blockIdx.x == 0 && threadIdx.x >= 64 && threadIdx.x < 128) ((unsigned*)(p.ws + OFF_ZERO))[threadIdx.x - 64] = 0u;
  unsigned nbar = 0;
  for (int ph = ph0; ph < ph1; ++ph) {
    if (ph > ph0) {
      if (ph == ph0 + 1) cg::this_grid().sync();
      else { ++nbar; grid_barrier(bar, nbar * gridDim.x); }
    }
    const u16* H = (const u16*)(p.ws + OFF_H);
    u16* Hm = (u16*)(p.ws + OFF_H);
    const u16* Abuf = (const u16*)(p.ws + OFF_BIG);
    u16* Bm = (u16*)(p.ws + OFF_BIG);
    switch (ph) {
      case 0:
        for (int item = blockIdx.x; item < 6528; item += gridDim.x) phase0_item(p, item, lds);
        break;
      case 1: phase_ln(p, 0, 0, true, false, nullptr, 0, 0); break;
      case 2: { GemmArgs ga{H, DM, (const u16*)(p.ws + OFF_WT_IN), 1024, 9, 0, nullptr}; phase_gemm<EPI_INPROJ>(p, ga, lds); } break;
      case 3: phase_attn0(p, lds); break;
      case 5: phase_ln(p, 0, 1, true, false, Abuf, 0, 2048); break;
      case 6: { GemmArgs ga{H, DM, (const u16*)(p.ws + OFF_WT_UP0), 1024, 22, 0, nullptr}; phase_gemm<EPI_UP>(p, ga, lds); } break;
      case 8: phase_ln(p, 1, 0, false, false, H, 0, 5120); break;
      case 9: { GemmArgs ga{H, DM, (const u16*)(p.ws + OFF_WT_QKV), 1024, 12, 1, nullptr}; phase_gemm<EPI_QKV1>(p, ga, lds); } break;
      case 10: phase_na(p, lds); break;
      case 12: phase_ln(p, 1, 1, false, false, Abuf, 1, 2048); break;
      case 13: { GemmArgs ga{H, DM, (const u16*)(p.ws + OFF_WT_UP1), 1024, 22, 1, nullptr}; phase_gemm<EPI_UP>(p, ga, lds); } break;
      case 15: phase_ln(p, 0, 0, false, true, H, 1, 5120); break;
      case 4: case 7: case 11: case 14: {
        GemmArgs ga;
        if (ph == 4) ga = GemmArgs{H, DM, (const u16*)(p.ws + OFF_WT_OUT0), 1024, 4, 0, Bm};
        else if (ph == 7) ga = GemmArgs{Abuf, DFF, (const u16*)(p.ws + OFF_WT_DN0), 2816, 4, 0, Hm};
        else if (ph == 11) ga = GemmArgs{H, DM, (const u16*)(p.ws + OFF_WT_OUT1), 1024, 4, 1, Bm};
        else ga = GemmArgs{Abuf, DFF, (const u16*)(p.ws + OFF_WT_DN1), 2816, 4, 1, Hm};
        phase_gemm<EPI_M>(p, ga, lds);
      } break;
      default: break;
    }
  }
}

extern "C" void kernel_launch(void* const* d_in, const int* in_sizes, int n_in, void* d_out, int out_size,
                              void* d_ws, size_t ws_size, hipStream_t stream) {
  static int grid_blocks = 0;
  if (!grid_blocks) {
    int dev = 0, cus = 0, per_cu = 0;
    hipGetDevice(&dev);
    hipDeviceGetAttribute(&cus, hipDeviceAttributeMultiprocessorCount, dev);
    hipOccupancyMaxActiveBlocksPerMultiprocessor(&per_cu, mega, NTHR, 0);
    if (per_cu < 1) per_cu = 1;
    if (per_cu > 1) per_cu = 1;
    grid_blocks = cus * per_cu;
    if (grid_blocks > 256) grid_blocks = 256;
    if (grid_blocks < 1) grid_blocks = 1;
  }
  if (ws_size < WS_NEEDED) fprintf(stderr, "workspace too small: %zu < %zu\n", ws_size, (size_t)WS_NEEDED);
  Params p{};
  p.x_prompt = (const float*)d_in[0]; p.x_sample = (const float*)d_in[1];
  p.c_prompt = (const float*)d_in[2]; p.c_sample = (const float*)d_in[3];
  p.ada_w = (const float*)d_in[4]; p.ada_b = (const float*)d_in[5]; p.norm_g = (const float*)d_in[6];
  p.even_w_in = (const float*)d_in[7]; p.even_w_out = (const float*)d_in[8];
  p.diff_lambda = (const float*)d_in[9]; p.diff_subln_g = (const float*)d_in[10]; p.gqa_qk_g = (const float*)d_in[11];
  p.odd_w_qkv = (const float*)d_in[12]; p.odd_rpb = (const float*)d_in[13]; p.odd_w_out = (const float*)d_in[14];
  p.ffn_w_up = (const float*)d_in[15]; p.ffn_conv_w = (const float*)d_in[16]; p.ffn_conv_b = (const float*)d_in[17];
  p.ffn_w_down = (const float*)d_in[18]; p.final_g = (const float*)d_in[19];
  p.out = (float*)d_out;
  p.ws = (char*)d_ws;
#if ONE_LAUNCH
  int ph0 = 0, ph1 = NPHASE;
  void* args[] = {&p, &ph0, &ph1};
  hipError_t e = hipLaunchCooperativeKernel((void*)mega, dim3(grid_blocks), dim3(NTHR), args, 0, stream);
  if (e != hipSuccess) fprintf(stderr, "cooperative launch failed: %s (grid %d)\n", hipGetErrorString(e), grid_blocks);
#else
  for (int ph = 0; ph < NPHASE; ++ph) mega<<<dim3(grid_blocks), dim3(NTHR), 0, stream>>>(p, ph, ph + 1);
#endif
}
```

```cpp
#include <hip/hip_runtime.h>
#include <hip/hip_cooperative_groups.h>
#include <cstdio>
namespace cg = cooperative_groups;

typedef unsigned short u16;
typedef __attribute__((ext_vector_type(8))) short bf16x8;
typedef __attribute__((ext_vector_type(16))) float f32x16;
typedef __attribute__((ext_vector_type(4))) unsigned u32x4;
typedef __attribute__((ext_vector_type(2))) unsigned u32x2;
typedef __attribute__((ext_vector_type(2))) float f32x2;
typedef __attribute__((ext_vector_type(2))) __bf16 bf16v2;

#define DI __device__ __forceinline__
#define MFMA(a, b, c) __builtin_amdgcn_mfma_f32_32x32x16_bf16((a), (b), (c), 0, 0, 0)

#ifndef ONE_LAUNCH
#define ONE_LAUNCH 1
#endif

constexpr int NTHR = 512;
constexpr int DM = 1024;
constexpr int NTOK = 49152;
constexpr int NTOK_P = 32768;
constexpr int SP = 16384, SS = 2048;
constexpr int DFF = 2816;
constexpr int QK0_LD = 1664;
constexpr int QK1_LD = 2048;
constexpr int NPHASE = 16;

constexpr size_t OFF_WT_IN = 0;
constexpr size_t OFF_WT_OUT0 = OFF_WT_IN + (size_t)2304 * 1024 * 2;
constexpr size_t OFF_WT_UP0 = OFF_WT_OUT0 + (size_t)1024 * 1024 * 2;
constexpr size_t OFF_WT_UP1 = OFF_WT_UP0 + (size_t)5632 * 1024 * 2;
constexpr size_t OFF_WT_DN0 = OFF_WT_UP1 + (size_t)5632 * 1024 * 2;
constexpr size_t OFF_WT_DN1 = OFF_WT_DN0 + (size_t)1024 * 2816 * 2;
constexpr size_t OFF_WT_QKV = OFF_WT_DN1 + (size_t)1024 * 2816 * 2;
constexpr size_t OFF_WT_OUT1 = OFF_WT_QKV + (size_t)3072 * 1024 * 2;
constexpr size_t OFF_MOD = OFF_WT_OUT1 + (size_t)1024 * 1024 * 2;
constexpr size_t OFF_CS1 = OFF_MOD + (size_t)2 * 10 * 6144 * 4;
constexpr size_t OFF_CS2 = OFF_CS1 + (size_t)16384 * 32 * 8;
constexpr size_t OFF_H = OFF_CS2 + (size_t)16384 * 32 * 8;
constexpr size_t OFF_BIG = OFF_H + (size_t)NTOK * 1024 * 2;
constexpr size_t BIG_BYTES = (size_t)NTOK * 3072 * 2;
constexpr size_t OFF_VT0 = OFF_BIG + (size_t)NTOK * QK0_LD * 2;
constexpr size_t OFF_VT1 = OFF_BIG + (size_t)NTOK * QK1_LD * 2;
constexpr size_t OFF_STASH = OFF_BIG + BIG_BYTES;
constexpr size_t STASH_PER_BLOCK = (size_t)8 * 64 * 64 * 4;
constexpr size_t OFF_BAR = OFF_STASH + 256 * STASH_PER_BLOCK;
constexpr size_t OFF_ZERO = OFF_BAR + 4096;
constexpr size_t WS_NEEDED = OFF_ZERO + 256;

constexpr int LDS_BYTES = 133120;
constexpr float QK_SCALE_LOG2 = 0.125f * 1.4426950408889634f;

__device__ const float INV1[32] = {1.000000000e+00f, 7.498942614e-01f, 5.623413324e-01f, 4.216965139e-01f, 3.162277639e-01f, 2.371373773e-01f, 1.778279394e-01f, 1.333521307e-01f, 1.000000015e-01f, 7.498941571e-02f, 5.623413250e-02f, 4.216965288e-02f, 3.162277490e-02f, 2.371373773e-02f, 1.778279431e-02f, 1.333521493e-02f, 9.999999776e-03f, 7.498941850e-03f, 5.623413250e-03f, 4.216964822e-03f, 3.162277630e-03f, 2.371373586e-03f, 1.778279431e-03f, 1.333521446e-03f, 1.000000047e-03f, 7.498942432e-04f, 5.623413017e-04f, 4.216965172e-04f, 3.162277571e-04f, 2.371373703e-04f, 1.778279402e-04f, 1.333521504e-04f};
__device__ const float INV2[16] = {1.000000000e+00f, 5.623413324e-01f, 3.162277639e-01f, 1.778279394e-01f, 1.000000015e-01f, 5.623413250e-02f, 3.162277490e-02f, 1.778279431e-02f, 9.999999776e-03f, 5.623413250e-03f, 3.162277630e-03f, 1.778279431e-03f, 1.000000047e-03f, 5.623413017e-04f, 3.162277571e-04f, 1.778279402e-04f};

struct Params {
  const float *x_prompt, *x_sample, *c_prompt, *c_sample, *ada_w, *ada_b, *norm_g, *even_w_in, *even_w_out,
      *diff_lambda, *diff_subln_g, *gqa_qk_g, *odd_w_qkv, *odd_rpb, *odd_w_out, *ffn_w_up, *ffn_conv_w,
      *ffn_conv_b, *ffn_w_down, *final_g;
  float* out;
  char* ws;
};

DI unsigned pk_bf16(float a, float b) {
  f32x2 v = {a, b};
  bf16v2 r = __builtin_convertvector(v, bf16v2);
  return __builtin_bit_cast(unsigned, r);
}
DI u16 to_bf16(float a) { return (u16)(pk_bf16(a, 0.f) & 0xffffu); }
DI float bf16_to_f(u16 v) { return __uint_as_float(((unsigned)v) << 16); }
DI void half_swap(u32x2& X, u32x2& Y) {
  typedef __attribute__((ext_vector_type(2))) unsigned u2_;
  const u2_ a = __builtin_amdgcn_permlane32_swap(X.x, Y.x, false, false);
  const u2_ b = __builtin_amdgcn_permlane32_swap(X.y, Y.y, false, false);
  X.x = a.x; Y.x = a.y; X.y = b.x; Y.y = b.y;
}
DI int opaque_tid() { int t = threadIdx.x; asm volatile("" : "+v"(t)); return t; }
DI float fexp2(float x) { return __builtin_amdgcn_exp2f(x); }
DI int swz(int row, int chunk) { return row * 128 + ((chunk ^ ((row >> 1) & 7)) << 4); }
DI int crow(int i, int h) { return (i & 3) + 8 * (i >> 2) + 4 * h; }
DI void seq_of_token(int t, int& bb, int& tokbase, int& S) {
  if (t < NTOK_P) { bb = t >> 14; tokbase = bb << 14; S = SP; }
  else { int u = (t - NTOK_P) >> 11; bb = 2 + u; tokbase = NTOK_P + (u << 11); S = SS; }
}
DI const float* xin_row(const Params& p, int t) {
  return (t < NTOK_P) ? (p.x_prompt + (size_t)t * DM) : (p.x_sample + (size_t)(t - NTOK_P) * DM);
}
DI int logical_index(int it) {
  const int G = gridDim.x, b = blockIdx.x;
  if ((G & 7) == 0) return it * G + (b & 7) * (G >> 3) + (b >> 3);
  return it * G + b;
}

DI void phase0_item(const Params& p, int item, char* lds) {
  const int tid = opaque_tid();
  if (item < 192) {
    const int l = item / 96, jc = item % 96;
    float* cact = (float*)lds;
    float* red = (float*)(lds + 40960);
    for (int e = tid; e < 10240; e += NTHR) {
      int bb = e >> 10, k = e & 1023;
      float c = (bb < 2) ? p.c_prompt[bb * 1024 + k] : p.c_sample[(bb - 2) * 1024 + k];
      cact[e] = c / (1.f + __expf(-c));
    }
    __syncthreads();
    const int col = tid & 63, kg = tid >> 6;
    float acc[10];
#pragma unroll
    for (int b = 0; b < 10; ++b) acc[b] = 0.f;
    const float* w = p.ada_w + (size_t)l * 1024 * 6144 + (size_t)(kg * 128) * 6144 + jc * 64 + col;
#pragma unroll 8
    for (int k = 0; k < 128; ++k) {
      float wv = w[(size_t)k * 6144];
#pragma unroll
      for (int b = 0; b < 10; ++b) acc[b] += cact[b * 1024 + kg * 128 + k] * wv;
    }
#pragma unroll
    for (int b = 0; b < 10; ++b) red[(kg * 10 + b) * 64 + col] = acc[b];
    __syncthreads();
    for (int e = tid; e < 640; e += NTHR) {
      int b = e >> 6, c = e & 63;
      float s = p.ada_b[l * 6144 + jc * 64 + c];
#pragma unroll
      for (int g = 0; g < 8; ++g) s += red[(g * 10 + b) * 64 + c];
      ((float*)(p.ws + OFF_MOD))[(l * 10 + b) * 6144 + jc * 64 + c] = s;
    }
    __syncthreads();
    return;
  }
  item -= 192;
  if (item < 6080) {
    const float* src; u16* dst; int K, N, perm = 0, tl;
    if (item < 576) { src = p.even_w_in; dst = (u16*)(p.ws + OFF_WT_IN); K = 1024; N = 2304; tl = item; }
    else if (item < 832) { src = p.even_w_out; dst = (u16*)(p.ws + OFF_WT_OUT0); K = 1024; N = 1024; tl = item - 576; }
    else if (item < 2240) { src = p.ffn_w_up; dst = (u16*)(p.ws + OFF_WT_UP0); K = 1024; N = 5632; perm = 1; tl = item - 832; }
    else if (item < 3648) { src = p.ffn_w_up + (size_t)1024 * 5632; dst = (u16*)(p.ws + OFF_WT_UP1); K = 1024; N = 5632; perm = 1; tl = item - 2240; }
    else if (item < 4352) { src = p.ffn_w_down; dst = (u16*)(p.ws + OFF_WT_DN0); K = 2816; N = 1024; tl = item - 3648; }
    else if (item < 5056) { src = p.ffn_w_down + (size_t)2816 * 1024; dst = (u16*)(p.ws + OFF_WT_DN1); K = 2816; N = 1024; tl = item - 4352; }
    else if (item < 5824) { src = p.odd_w_qkv; dst = (u16*)(p.ws + OFF_WT_QKV); K = 1024; N = 3072; tl = item - 5056; }
    else { src = p.odd_w_out; dst = (u16*)(p.ws + OFF_WT_OUT1); K = 1024; N = 1024; tl = item - 5824; }
    const int ntn = N >> 6;
    const int k0 = (tl / ntn) << 6, n0 = (tl % ntn) << 6;
    float* T = (float*)lds;
    const int a = tid >> 6, c = tid & 63;
#pragma unroll
    for (int i = 0; i < 8; ++i) {
      int kk = a + 8 * i;
      T[kk * 65 + c] = src[(size_t)(k0 + kk) * N + n0 + c];
    }
    __syncthreads();
#pragma unroll
    for (int i = 0; i < 8; ++i) {
      int nn = a + 8 * i;
      int n = n0 + nn;
      int row = n;
      if (perm) {
        if (n < DFF) row = ((n >> 7) << 8) + (n & 127);
        else { int n2 = n - DFF; row = ((n2 >> 7) << 8) + 128 + (n2 & 127); }
      }
      dst[(size_t)row * K + k0 + c] = to_bf16(T[c * 65 + nn]);
    }
    __syncthreads();
    return;
  }
  item -= 6080;
  {
#pragma unroll
    for (int i = 0; i < 8; ++i) {
      int e = item * 4096 + i * 512 + tid;
      int tab = e >> 19;
      int ee = e & 524287;
      int t = ee >> 5, j = ee & 31;
      float ang;
      if (tab == 0) ang = (float)t * INV1[j];
      else ang = (j < 16) ? (float)(t >> 6) * INV2[j] : (float)(t & 63) * INV2[j - 16];
      double rev = (double)ang * 0.15915494309189533577;
      double fr = rev - rint(rev);
      float f = (float)fr;
      f32x2 cs = {__builtin_amdgcn_cosf(f), __builtin_amdgcn_sinf(f)};
      ((f32x2*)(p.ws + (tab ? OFF_CS2 : OFF_CS1)))[ee] = cs;
    }
  }
}

DI void phase_ln(const Params& p, int layer, int sub, bool first, bool final_, const u16* M, int glayer, int goff) {
  const int tid = opaque_tid(), lane = tid & 63, w = tid >> 6;
  const float* gn = final_ ? p.final_g : (p.norm_g + (layer * 2 + sub) * 1024);
  const float* mod = (const float*)(p.ws + OFF_MOD);
  u16* H = (u16*)(p.ws + OFF_H);
  const int nw = gridDim.x * 8, gw = blockIdx.x * 8 + w;
  const int rows_per = (NTOK + nw - 1) / nw;
  const int r0 = gw * rows_per;
  const int r1 = (r0 + rows_per < NTOK) ? (r0 + rows_per) : NTOK;
  if (r0 >= r1) return;
  auto load_row = [&](int row, float4 (&v)[4], u32x2 (&mm)[4]) {
    const float* xr = first ? xin_row(p, row) : (p.out + (size_t)row * DM);
#pragma unroll
    for (int j = 0; j < 4; ++j) v[j] = *(const float4*)(xr + j * 256 + lane * 4);
    if (M) {
#pragma unroll
      for (int j = 0; j < 4; ++j) mm[j] = *(const u32x2*)(M + (size_t)row * DM + j * 256 + lane * 4);
    }
  };
  float4 pg[4], psh[4], pgm[4];
  int cur_bb = -1;
  float4 v[4], vn[4], vn2[4];
  u32x2 mm[4], mmn[4], mmn2[4];
#pragma unroll
  for (int j = 0; j < 4; ++j) {
    mm[j] = (u32x2){0u, 0u}; mmn[j] = (u32x2){0u, 0u}; mmn2[j] = (u32x2){0u, 0u};
    vn[j] = (float4){0.f, 0.f, 0.f, 0.f}; vn2[j] = (float4){0.f, 0.f, 0.f, 0.f};
  }
  load_row(r0, v, mm);
  if (r0 + 1 < r1) load_row(r0 + 1, vn, mmn);
  for (int row = r0; row < r1; ++row) {
    if (row + 2 < r1) load_row(row + 2, vn2, mmn2);
    int bb, tokbase, S;
    seq_of_token(row, bb, tokbase, S);
    if (bb != cur_bb) {
      cur_bb = bb;
      const float* mrow = mod + (layer * 10 + bb) * 6144 + sub * 3072;
      const float* grow = mod + (glayer * 10 + bb) * 6144 + goff;
#pragma unroll
      for (int j = 0; j < 4; ++j) {
        const int c = j * 256 + lane * 4;
        const float4 g = *(const float4*)(gn + c);
        if (final_) { pg[j] = g; psh[j] = (float4){0.f, 0.f, 0.f, 0.f}; }
        else {
          const float4 sh = *(const float4*)(mrow + c);
          const float4 sc = *(const float4*)(mrow + 1024 + c);
          pg[j] = (float4){g.x * (1.f + sc.x), g.y * (1.f + sc.y), g.z * (1.f + sc.z), g.w * (1.f + sc.w)};
          psh[j] = sh;
        }
        if (M) pgm[j] = *(const float4*)(grow + c);
      }
    }
    if (M) {
#pragma unroll
      for (int j = 0; j < 4; ++j) {
        const int c = j * 256 + lane * 4;
        v[j].x += pgm[j].x * __uint_as_float(mm[j].x << 16);
        v[j].y += pgm[j].y * __uint_as_float(mm[j].x & 0xffff0000u);
        v[j].z += pgm[j].z * __uint_as_float(mm[j].y << 16);
        v[j].w += pgm[j].w * __uint_as_float(mm[j].y & 0xffff0000u);
        if (!final_) *(float4*)(p.out + (size_t)row * DM + c) = v[j];
      }
    }
    float ss = 0.f;
#pragma unroll
    for (int j = 0; j < 4; ++j) ss += v[j].x * v[j].x + v[j].y * v[j].y + v[j].z * v[j].z + v[j].w * v[j].w;
#pragma unroll
    for (int o = 1; o < 64; o <<= 1) ss += __shfl_xor(ss, o);
    const float rstd = rsqrtf(ss * (1.f / 1024.f) + 1e-6f);
    if (final_) {
#pragma unroll
      for (int j = 0; j < 4; ++j) {
        float4 o4 = {v[j].x * rstd * pg[j].x, v[j].y * rstd * pg[j].y, v[j].z * rstd * pg[j].z, v[j].w * rstd * pg[j].w};
        *(float4*)(p.out + (size_t)row * DM + j * 256 + lane * 4) = o4;
      }
    } else {
#pragma unroll
      for (int j = 0; j < 4; ++j) {
        const int c = j * 256 + lane * 4;
        const float a0 = v[j].x * rstd * pg[j].x + psh[j].x;
        const float a1 = v[j].y * rstd * pg[j].y + psh[j].y;
        const float a2 = v[j].z * rstd * pg[j].z + psh[j].z;
        const float a3 = v[j].w * rstd * pg[j].w + psh[j].w;
        u32x2 o2 = {pk_bf16(a0, a1), pk_bf16(a2, a3)};
        *(u32x2*)(H + (size_t)row * DM + c) = o2;
      }
    }
#pragma unroll
    for (int j = 0; j < 4; ++j) { v[j] = vn[j]; mm[j] = mmn[j]; vn[j] = vn2[j]; mmn[j] = mmn2[j]; }
  }
}

template <bool SWAP>
DI void gemm_mainloop(f32x16 (&acc)[4][2], const u16* __restrict__ A, int lda, int rlo, int rhi,
                      const u16* __restrict__ B, int ldb, int K, char* lds, const u16* zero_line) {
  const int tid = opaque_tid(), lane = tid & 63, w = tid >> 6;
  const int wm = w >> 2, wn = w & 3;
  const int h = lane >> 5, r = lane & 31;
  const int lr = tid >> 3, lc = tid & 7;
#pragma unroll
  for (int mi = 0; mi < 4; ++mi)
#pragma unroll
    for (int ni = 0; ni < 2; ++ni)
#pragma unroll
      for (int i = 0; i < 16; ++i) acc[mi][ni][i] = 0.f;
  const int gch = (lc ^ ((lr >> 1) & 7)) * 8;
  const u16* ap = A + (ptrdiff_t)lr * lda + gch;
  const u16* bp = B + (ptrdiff_t)lr * ldb + gch;
  const int nk = K >> 6;
  typedef __attribute__((address_space(3))) unsigned lds_u32;
  auto glds = [&](int kt, int st) {
    char* as_ = lds + st * 65536 + tid * 16;
#pragma unroll
    for (int i = 0; i < 4; ++i) {
      const int rr = lr + 64 * i;
      const u16* srca = (rr >= rlo && rr < rhi) ? (ap + (ptrdiff_t)(64 * i) * lda + kt * 64) : (zero_line + lc * 8);
      __builtin_amdgcn_global_load_lds((const unsigned*)srca, (lds_u32*)(as_ + i * 8192), 16, 0, 0);
      __builtin_amdgcn_global_load_lds((const unsigned*)(bp + (ptrdiff_t)(64 * i) * ldb + kt * 64), (lds_u32*)(as_ + 32768 + i * 8192), 16, 0, 0);
    }
  };
  const int sw = (r >> 1) & 7;
  const int arow_off = (wm * 128 + r) * 128;
  const int brow_off = 32768 + (wn * 64 + r) * 128;
  __syncthreads();
  glds(0, 0);
  asm volatile("s_waitcnt vmcnt(0)" ::: "memory");
  __syncthreads();
  bf16x8 fa[2][4], fb[2][2];
#pragma unroll
  for (int mi = 0; mi < 4; ++mi)
#pragma unroll
    for (int e = 0; e < 8; ++e) fa[1][mi][e] = 0;
#pragma unroll
  for (int ni = 0; ni < 2; ++ni)
#pragma unroll
    for (int e = 0; e < 8; ++e) fb[1][ni][e] = 0;
  auto ldfrag = [&](const char* st, int ks, int buf) {
    const int co = ((2 * ks + h) ^ sw) << 4;
#pragma unroll
    for (int mi = 0; mi < 4; ++mi) fa[buf][mi] = *(const bf16x8*)(st + arow_off + mi * 4096 + co);
#pragma unroll
    for (int ni = 0; ni < 2; ++ni) fb[buf][ni] = *(const bf16x8*)(st + brow_off + ni * 4096 + co);
  };
  auto mma = [&](int buf) {
#pragma unroll
    for (int mi = 0; mi < 4; ++mi)
#pragma unroll
      for (int ni = 0; ni < 2; ++ni)
        acc[mi][ni] = SWAP ? MFMA(fb[buf][ni], fa[buf][mi], acc[mi][ni]) : MFMA(fa[buf][mi], fb[buf][ni], acc[mi][ni]);
  };
  auto pat_rd = [&]() {
#pragma unroll
    for (int g = 0; g < 6; ++g) {
      __builtin_amdgcn_sched_group_barrier(0x100, 1, 0);
      __builtin_amdgcn_sched_group_barrier(0x008, 1, 0);
    }
    __builtin_amdgcn_sched_group_barrier(0x008, 2, 0);
  };
  for (int kt = 0; kt < nk; ++kt) {
    const char* st = lds + (kt & 1) * 65536;
    ldfrag(st, 0, 0);
    mma(1);
    pat_rd();
    if (kt + 1 < nk) glds(kt + 1, (kt + 1) & 1);
    ldfrag(st, 1, 1);
    mma(0);
    pat_rd();
    ldfrag(st, 2, 0);
    mma(1);
    pat_rd();
    ldfrag(st, 3, 1);
    mma(0);
    pat_rd();
    asm volatile("s_waitcnt vmcnt(0)" ::: "memory");
    __syncthreads();
  }
  mma(1);
}

DI void tile_mn(int t, int Mt, int Nt, int& m, int& n) {
  const int per = 8 * Nt;
  int g = t / per;
  int rem = t - g * per;
  int gs = Mt - g * 8;
  if (gs > 8) gs = 8;
  n = rem / gs;
  m = g * 8 + (rem - n * gs);
}

enum { EPI_INPROJ = 0, EPI_M = 1, EPI_UP = 2, EPI_QKV1 = 3 };

struct GemmArgs {
  const u16* A; int lda; const u16* Bt; int K; int Nt; int layer; u16* Mout;
};

template <int EPI>
DI void phase_gemm(const Params& p, const GemmArgs& ga, char* lds) {
  const int tid = opaque_tid(), lane = tid & 63, w = tid >> 6;
  const int wm = w >> 2, wn = w & 3;
  const int h = lane >> 5, r = lane & 31;
  const int Mt = (EPI == EPI_UP) ? 194 : 192;
  const int total = Mt * ga.Nt;
  for (int it = 0; it * (int)gridDim.x < total; ++it) {
    const int lt = logical_index(it);
    if (lt >= total) continue;
    int mt, nt;
    tile_mn(lt, Mt, ga.Nt, mt, nt);
    int bb, tokbase, S, pos0, rlo = 0, rhi = 256;
    if (EPI == EPI_UP) {
      bb = 0; tokbase = 0; S = NTOK;
      pos0 = 254 * mt - 1;
      rlo = (mt == 0) ? 1 : 0;
      rhi = NTOK - pos0; if (rhi > 256) rhi = 256;
    } else {
      seq_of_token(mt * 256, bb, tokbase, S);
      pos0 = mt * 256 - tokbase;
    }
    const u16* A = ga.A + (ptrdiff_t)(tokbase + pos0) * ga.lda;
    const u16* B = ga.Bt + (size_t)(nt * 256) * ga.K;
    f32x16 acc[4][2];
    bool swap;
    if (EPI == EPI_M) swap = true;
    else if (EPI == EPI_UP) swap = true;
    else if (EPI == EPI_QKV1) swap = (nt < 8);
    else swap = !(nt == 4 || nt == 5);
    if (swap) gemm_mainloop<true>(acc, A, ga.lda, rlo, rhi, B, ga.K, ga.K, lds, (const u16*)(p.ws + OFF_ZERO));
    else gemm_mainloop<false>(acc, A, ga.lda, rlo, rhi, B, ga.K, ga.K, lds, (const u16*)(p.ws + OFF_ZERO));

    const int n0w = nt * 256 + wn * 64;
    if (EPI == EPI_M) {
      u16* mo = ga.Mout + (size_t)(tokbase + pos0 + wm * 128 + r) * DM + n0w + 8 * h;
#pragma unroll
      for (int mi = 0; mi < 4; ++mi)
#pragma unroll
        for (int ni = 0; ni < 2; ++ni)
#pragma unroll
          for (int jp = 0; jp < 2; ++jp) {
            u32x2 X = {pk_bf16(acc[mi][ni][8 * jp], acc[mi][ni][8 * jp + 1]), pk_bf16(acc[mi][ni][8 * jp + 2], acc[mi][ni][8 * jp + 3])};
            u32x2 Y = {pk_bf16(acc[mi][ni][8 * jp + 4], acc[mi][ni][8 * jp + 5]), pk_bf16(acc[mi][ni][8 * jp + 6], acc[mi][ni][8 * jp + 7])};
            half_swap(X, Y);
            u32x4 v = {X.x, X.y, Y.x, Y.y};
            *(u32x4*)(mo + (size_t)(mi * 32) * DM + ni * 32 + 16 * jp) = v;
          }
    } else if (EPI == EPI_QKV1) {
      u16* QK = (u16*)(p.ws + OFF_BIG);
      u16* VT = (u16*)(p.ws + OFF_VT1);
      if (swap) {
        const float sc = (n0w < 1024) ? QK_SCALE_LOG2 : 1.f;
        u16* qo = QK + (size_t)(tokbase + pos0 + wm * 128 + r) * QK1_LD + n0w + 8 * h;
#pragma unroll
        for (int mi = 0; mi < 4; ++mi)
#pragma unroll
          for (int ni = 0; ni < 2; ++ni)
#pragma unroll
            for (int jp = 0; jp < 2; ++jp) {
              u32x2 X = {pk_bf16(acc[mi][ni][8 * jp] * sc, acc[mi][ni][8 * jp + 1] * sc), pk_bf16(acc[mi][ni][8 * jp + 2] * sc, acc[mi][ni][8 * jp + 3] * sc)};
              u32x2 Y = {pk_bf16(acc[mi][ni][8 * jp + 4] * sc, acc[mi][ni][8 * jp + 5] * sc), pk_bf16(acc[mi][ni][8 * jp + 6] * sc, acc[mi][ni][8 * jp + 7] * sc)};
              half_swap(X, Y);
              u32x4 v = {X.x, X.y, Y.x, Y.y};
              *(u32x4*)(qo + (size_t)(mi * 32) * QK1_LD + ni * 32 + 16 * jp) = v;
            }
      } else {
#pragma unroll
        for (int ni = 0; ni < 2; ++ni) {
          const int vrow = n0w - 2048 + ni * 32 + r;
          u16* vb = VT + (size_t)1024 * tokbase + (size_t)vrow * S;
#pragma unroll
          for (int mi = 0; mi < 4; ++mi)
#pragma unroll
            for (int jp = 0; jp < 2; ++jp) {
              const int pos = pos0 + wm * 128 + mi * 32 + 16 * jp + 8 * h;
              u32x2 X = {pk_bf16(acc[mi][ni][8 * jp], acc[mi][ni][8 * jp + 1]), pk_bf16(acc[mi][ni][8 * jp + 2], acc[mi][ni][8 * jp + 3])};
              u32x2 Y = {pk_bf16(acc[mi][ni][8 * jp + 4], acc[mi][ni][8 * jp + 5]), pk_bf16(acc[mi][ni][8 * jp + 6], acc[mi][ni][8 * jp + 7])};
              half_swap(X, Y);
              u32x4 v = {X.x, X.y, Y.x, Y.y};
              *(u32x4*)(vb + pos) = v;
            }
        }
      }
    } else if (EPI == EPI_INPROJ) {
      u16* QK = (u16*)(p.ws + OFF_BIG);
      u16* VT = (u16*)(p.ws + OFF_VT0);
      if (!swap) {
#pragma unroll
        for (int ni = 0; ni < 2; ++ni) {
          const int vrow = (n0w - 1024) + ni * 32 + r;
          u16* vb = VT + (size_t)640 * tokbase + (size_t)vrow * S;
#pragma unroll
          for (int mi = 0; mi < 4; ++mi)
#pragma unroll
            for (int jp = 0; jp < 2; ++jp) {
              const int pos = pos0 + wm * 128 + mi * 32 + 16 * jp + 8 * h;
              u32x2 X = {pk_bf16(acc[mi][ni][8 * jp], acc[mi][ni][8 * jp + 1]), pk_bf16(acc[mi][ni][8 * jp + 2], acc[mi][ni][8 * jp + 3])};
              u32x2 Y = {pk_bf16(acc[mi][ni][8 * jp + 4], acc[mi][ni][8 * jp + 5]), pk_bf16(acc[mi][ni][8 * jp + 6], acc[mi][ni][8 * jp + 7])};
              half_swap(X, Y);
              u32x4 v = {X.x, X.y, Y.x, Y.y};
              *(u32x4*)(vb + pos) = v;
            }
        }
      } else if (n0w >= 2176) {
#pragma unroll
        for (int ni = 0; ni < 2; ++ni)
#pragma unroll
          for (int i = 0; i < 16; ++i) {
            const int vrow = 512 + (n0w - 2176) + ni * 32 + 8 * (i >> 2) + 4 * h + (i & 3);
            u16* vb = VT + (size_t)640 * tokbase + (size_t)vrow * S + pos0 + wm * 128 + r;
#pragma unroll
            for (int mi = 0; mi < 4; ++mi) vb[mi * 32] = to_bf16(acc[mi][ni][i]);
          }
      } else {
        const bool nrm = (n0w >= 1536);
        int dcol;
        const float* gq = p.gqa_qk_g;
        float osc = 1.f;
        if (n0w < 1024) { dcol = n0w; if (n0w < 512) osc = QK_SCALE_LOG2; }
        else if (n0w < 2048) { dcol = 1024 + (n0w - 1536); osc = QK_SCALE_LOG2; }
        else { dcol = 1536 + (n0w - 2048); gq += 64; }
        const float* cs = (const float*)(p.ws + (nrm ? OFF_CS2 : OFF_CS1));
#pragma unroll
        for (int mi = 0; mi < 4; ++mi) {
          const int pos = pos0 + wm * 128 + mi * 32 + r;
          float rs = 1.f;
          if (nrm) {
            float ss = 0.f;
#pragma unroll
            for (int i = 0; i < 16; ++i) ss += acc[mi][0][i] * acc[mi][0][i] + acc[mi][1][i] * acc[mi][1][i];
            ss += __shfl_xor(ss, 32);
            rs = rsqrtf(ss * (1.f / 64.f) + 1e-6f);
          }
          u16* q = QK + (size_t)(tokbase + pos) * QK0_LD + dcol + 8 * h;
          const float* csr = cs + (size_t)pos * 64 + 8 * h;
#pragma unroll
          for (int jp = 0; jp < 2; ++jp) {
            u32x2 v1[2], v2[2];
#pragma unroll
            for (int jj = 0; jj < 2; ++jj) {
              const int j = 2 * jp + jj;
              const float4 ca = *(const float4*)(csr + 16 * j);
              const float4 cb = *(const float4*)(csr + 16 * j + 4);
              float x1[4], x2[4];
#pragma unroll
              for (int e = 0; e < 4; ++e) { x1[e] = acc[mi][0][4 * j + e]; x2[e] = acc[mi][1][4 * j + e]; }
              if (nrm) {
                const float4 ga_ = *(const float4*)(gq + 8 * j + 4 * h);
                const float4 gb_ = *(const float4*)(gq + 32 + 8 * j + 4 * h);
                x1[0] *= rs * ga_.x; x1[1] *= rs * ga_.y; x1[2] *= rs * ga_.z; x1[3] *= rs * ga_.w;
                x2[0] *= rs * gb_.x; x2[1] *= rs * gb_.y; x2[2] *= rs * gb_.z; x2[3] *= rs * gb_.w;
              }
              const float cc[4] = {ca.x, ca.z, cb.x, cb.z};
              const float sn[4] = {ca.y, ca.w, cb.y, cb.w};
              float y1[4], y2[4];
#pragma unroll
              for (int e = 0; e < 4; ++e) {
                y1[e] = (x1[e] * cc[e] - x2[e] * sn[e]) * osc;
                y2[e] = (x2[e] * cc[e] + x1[e] * sn[e]) * osc;
              }
              v1[jj] = (u32x2){pk_bf16(y1[0], y1[1]), pk_bf16(y1[2], y1[3])};
              v2[jj] = (u32x2){pk_bf16(y2[0], y2[1]), pk_bf16(y2[2], y2[3])};
            }
            half_swap(v1[0], v1[1]);
            half_swap(v2[0], v2[1]);
            u32x4 w1 = {v1[0].x, v1[0].y, v1[1].x, v1[1].y};
            u32x4 w2 = {v2[0].x, v2[0].y, v2[1].x, v2[1].y};
            *(u32x4*)(q + 16 * jp) = w1;
            *(u32x4*)(q + 32 + 16 * jp) = w2;
          }
        }
      }
    } else {
      __syncthreads();
      constexpr int RS = 520;
      {
        char* wbase = lds + (wm * 128 + r) * RS + (wn * 64 + 4 * h) * 2;
#pragma unroll
        for (int mi = 0; mi < 4; ++mi)
#pragma unroll
          for (int ni = 0; ni < 2; ++ni)
#pragma unroll
            for (int j = 0; j < 4; ++j) {
              u32x2 v = {pk_bf16(acc[mi][ni][4 * j], acc[mi][ni][4 * j + 1]), pk_bf16(acc[mi][ni][4 * j + 2], acc[mi][ni][4 * j + 3])};
              *(u32x2*)(wbase + mi * 32 * RS + (ni * 32 + 8 * j) * 2) = v;
            }
      }
      __syncthreads();
      {
        const int q4 = tid & 31, seg = tid >> 5;
        const int ch = nt * 128 + 4 * q4;
        const float* cw = p.ffn_conv_w + (size_t)ga.layer * 3 * 5632;
        const float* cb = p.ffn_conv_b + (size_t)ga.layer * 5632;
        float4 wg[3], wv[3];
#pragma unroll
        for (int t3 = 0; t3 < 3; ++t3) { wg[t3] = *(const float4*)(cw + t3 * 5632 + ch); wv[t3] = *(const float4*)(cw + t3 * 5632 + DFF + ch); }
        const float4 bg = *(const float4*)(cb + ch);
        const float4 bv = *(const float4*)(cb + DFF + ch);
        const char* gbase = lds + q4 * 8;
        const char* vbase = lds + 256 + q4 * 8;
        const int R0 = 1 + seg * 16;
        const int Rend = (R0 + 16 < 255) ? (R0 + 16) : 255;
        auto ld4 = [&](const char* b_, int R) -> float4 {
          const u32x2 u = *(const u32x2*)(b_ + R * RS);
          float4 f = {__uint_as_float(u.x << 16), __uint_as_float(u.x & 0xffff0000u), __uint_as_float(u.y << 16), __uint_as_float(u.y & 0xffff0000u)};
          return f;
        };
        float4 pg = ld4(gbase, R0 - 1), pvv = ld4(vbase, R0 - 1);
        float4 cg_ = ld4(gbase, R0), cv_ = ld4(vbase, R0);
        u16* Aout = (u16*)(p.ws + OFF_BIG) + (ptrdiff_t)(tokbase + pos0) * DFF + ch;
#pragma unroll 4
        for (int R = R0; R < Rend; ++R) {
          const float4 ng = ld4(gbase, R + 1), nv = ld4(vbase, R + 1);
          if (pos0 + R < S) {
            const int tflat = pos0 + R;
            const int ps = (tflat < NTOK_P) ? (tflat & (SP - 1)) : ((tflat - NTOK_P) & (SS - 1));
            const int Ss = (tflat < NTOK_P) ? SP : SS;
            const float mp = (ps == 0) ? 0.f : 1.f;
            const float mn = (ps == Ss - 1) ? 0.f : 1.f;
            float g[4], v[4];
            g[0] = mp * pg.x * wg[0].x + cg_.x * wg[1].x + mn * ng.x * wg[2].x + bg.x;
            g[1] = mp * pg.y * wg[0].y + cg_.y * wg[1].y + mn * ng.y * wg[2].y + bg.y;
            g[2] = mp * pg.z * wg[0].z + cg_.z * wg[1].z + mn * ng.z * wg[2].z + bg.z;
            g[3] = mp * pg.w * wg[0].w + cg_.w * wg[1].w + mn * ng.w * wg[2].w + bg.w;
            v[0] = mp * pvv.x * wv[0].x + cv_.x * wv[1].x + mn * nv.x * wv[2].x + bv.x;
            v[1] = mp * pvv.y * wv[0].y + cv_.y * wv[1].y + mn * nv.y * wv[2].y + bv.y;
            v[2] = mp * pvv.z * wv[0].z + cv_.z * wv[1].z + mn * nv.z * wv[2].z + bv.z;
            v[3] = mp * pvv.w * wv[0].w + cv_.w * wv[1].w + mn * nv.w * wv[2].w + bv.w;
            float a_[4];
#pragma unroll
            for (int e = 0; e < 4; ++e) a_[e] = g[e] * __builtin_amdgcn_rcpf(1.f + fexp2(-1.4426950408889634f * g[e])) * v[e];
            u32x2 ov = {pk_bf16(a_[0], a_[1]), pk_bf16(a_[2], a_[3])};
            *(u32x2*)(Aout + (ptrdiff_t)R * DFF) = ov;
          }
          pg = cg_; pvv = cv_; cg_ = ng; cv_ = nv;
        }
      }
    }
  }
}

constexpr int ATT_STAGE = 24576;
template <int DV, bool NA>
DI void flash_pass(f32x16 (&o)[DV / 32], const u16* __restrict__ Qp, const u16* __restrict__ Kb, int ldk,
                   const u16* __restrict__ Vt, int S, int tile0, int ntiles, char* lds, float cscale,
                   int wlo, int whi, const float* bias_lds, int r_w, int qc) {
  const int tid = opaque_tid(), lane = tid & 63;
  const int h = lane >> 5, r = lane & 31;
  bf16x8 q[4];
#pragma unroll
  for (int ks = 0; ks < 4; ++ks) q[ks] = *(const bf16x8*)(Qp + ks * 16 + h * 8);
#pragma unroll
  for (int mv = 0; mv < DV / 32; ++mv)
#pragma unroll
    for (int i = 0; i < 16; ++i) o[mv][i] = 0.f;
  float m_run = -INFINITY, l_run = 0.f;
  const int lr = tid >> 3, lc = tid & 7;
  const int wsw = lr * 128 + ((lc ^ ((lr >> 1) & 7)) << 4);
  u32x4 rk, rv[DV / 64];
  auto gload = [&](int ti) {
    const size_t key0 = (size_t)(tile0 + ti) * 64;
    rk = *(const u32x4*)(Kb + (key0 + lr) * ldk + lc * 8);
#pragma unroll
    for (int i = 0; i < DV / 64; ++i) rv[i] = *(const u32x4*)(Vt + (size_t)(lr + 64 * i) * S + key0 + lc * 8);
  };
  auto swrite = [&](int st) {
    char* ks_ = lds + st * ATT_STAGE;
    *(u32x4*)(ks_ + wsw) = rk;
#pragma unroll
    for (int i = 0; i < DV / 64; ++i) *(u32x4*)(ks_ + 8192 + i * 8192 + wsw) = rv[i];
  };
  const int pr = (r & 0x13) | ((r & 4) << 1) | ((r & 8) >> 1);
  const int ksw = (pr >> 1) & 7;
  const int vsw = (r >> 1) & 7;
  const int cs_ = NA ? min(max(qc - 8, 0), 48) : 0;
  __syncthreads();
  gload(0);
  swrite(0);
  if (ntiles > 1) gload(1);
  __syncthreads();
  for (int ti = 0; ti < ntiles; ++ti) {
    if (ti + 1 < ntiles) {
      swrite((ti + 1) & 1);
      if (ti + 2 < ntiles) gload(ti + 2);
    }
    const char* st = lds + (ti & 1) * ATT_STAGE;
    const bool active = !NA || ((tile0 + ti) >= wlo && (tile0 + ti) <= whi);
    if (active) {
      f32x16 s0, s1;
#pragma unroll
      for (int i = 0; i < 16; ++i) { s0[i] = 0.f; s1[i] = 0.f; }
      {
        bf16x8 ka[4], kb_[4];
#pragma unroll
        for (int ks = 0; ks < 4; ++ks) {
          const int co = ((2 * ks + h) ^ ksw) << 4;
          ka[ks] = *(const bf16x8*)(st + pr * 128 + co);
          kb_[ks] = *(const bf16x8*)(st + (32 + pr) * 128 + co);
        }
        asm volatile("" ::: "memory");
#pragma unroll
        for (int ks = 0; ks < 4; ++ks) {
          s0 = MFMA(ka[ks], q[ks], s0);
          s1 = MFMA(kb_[ks], q[ks], s1);
        }
      }
      bf16x8 vf0[2][DV / 32];
#pragma unroll
      for (int c2 = 0; c2 < 2; ++c2) {
        const int co = ((2 * c2 + h) ^ vsw) << 4;
#pragma unroll
        for (int mv = 0; mv < DV / 32; ++mv) vf0[c2][mv] = *(const bf16x8*)(st + 8192 + (mv * 32 + r) * 128 + co);
      }
      asm volatile("" ::: "memory");
      float t[32];
#pragma unroll
      for (int i = 0; i < 16; ++i) { t[i] = s0[i]; t[16 + i] = s1[i]; }
      if (NA) {
        const int kr = tile0 + ti;
        const int brow = (kr - r_w + 7) * 31;
#pragma unroll
        for (int e = 0; e < 32; ++e) {
          const int i = e & 15, j = i >> 2;
          const int kc = (e >> 4) * 32 + 16 * (j >> 1) + 8 * h + 4 * (j & 1) + (i & 3);
          const bool valid = (kc >= cs_) && (kc < cs_ + 16);
          const int bi = valid ? (brow + kc - qc + 15) : 0;
          const float bv = bias_lds[bi];
          t[e] = valid ? (t[e] + bv) : -INFINITY;
        }
      }
      float mx = t[0];
#pragma unroll
      for (int e = 1; e < 32; ++e) mx = fmaxf(mx, t[e]);
      {
        typedef __attribute__((ext_vector_type(2))) unsigned u2x_;
        const unsigned mu_ = __float_as_uint(mx);
        const u2x_ sw_ = __builtin_amdgcn_permlane32_swap(mu_, mu_, false, false);
        mx = fmaxf(__uint_as_float(sw_.x), __uint_as_float(sw_.y));
      }
      if (__builtin_amdgcn_ballot_w64(mx > m_run + 8.f) != 0ull) {
        const float m_new = fmaxf(m_run, mx);
        const float alpha = fexp2(m_run - m_new);
        l_run *= alpha;
        m_run = m_new;
#pragma unroll
        for (int mv = 0; mv < DV / 32; ++mv)
#pragma unroll
          for (int i = 0; i < 16; ++i) o[mv][i] *= alpha;
      }
      float ls = 0.f;
#pragma unroll
      for (int e = 0; e < 32; ++e) { t[e] = fexp2(t[e] - m_run); ls += t[e]; }
      l_run += ls;
      bf16x8 pf[2][2];
#pragma unroll
      for (int kb = 0; kb < 2; ++kb)
#pragma unroll
        for (int c2 = 0; c2 < 2; ++c2) {
          const int e0 = kb * 16 + c2 * 8;
          u32x4 pw = {pk_bf16(t[e0], t[e0 + 1]), pk_bf16(t[e0 + 2], t[e0 + 3]), pk_bf16(t[e0 + 4], t[e0 + 5]), pk_bf16(t[e0 + 6], t[e0 + 7])};
          pf[kb][c2] = __builtin_bit_cast(bf16x8, pw);
        }
      bf16x8 vf1[2][DV / 32];
#pragma unroll
      for (int c2 = 0; c2 < 2; ++c2) {
        const int co = ((4 + 2 * c2 + h) ^ vsw) << 4;
#pragma unroll
        for (int mv = 0; mv < DV / 32; ++mv) vf1[c2][mv] = *(const bf16x8*)(st + 8192 + (mv * 32 + r) * 128 + co);
      }
      asm volatile("" ::: "memory");
#pragma unroll
      for (int c2 = 0; c2 < 2; ++c2)
#pragma unroll
        for (int mv = 0; mv < DV / 32; ++mv) o[mv] = MFMA(vf0[c2][mv], pf[0][c2], o[mv]);
#pragma unroll
      for (int c2 = 0; c2 < 2; ++c2)
#pragma unroll
        for (int mv = 0; mv < DV / 32; ++mv) o[mv] = MFMA(vf1[c2][mv], pf[1][c2], o[mv]);
    }
    __syncthreads();
  }
  const float lt = l_run + __shfl_xor(l_run, 32);
  const float inv = 1.f / lt;
#pragma unroll
  for (int mv = 0; mv < DV / 32; ++mv)
#pragma unroll
    for (int i = 0; i < 16; ++i) o[mv][i] *= inv;
}


DI void flash_pass_q2(f32x16 (&o)[2][2], const u16* __restrict__ Qp0, const u16* __restrict__ Qp1,
                      const u16* __restrict__ Kb, int ldk, const u16* __restrict__ Vt, int S, int ntiles, char* lds) {
  const int tid = opaque_tid(), lane = tid & 63;
  const int h = lane >> 5, r = lane & 31;
  bf16x8 q[2][4];
#pragma unroll
  for (int ks = 0; ks < 4; ++ks) {
    q[0][ks] = *(const bf16x8*)(Qp0 + ks * 16 + h * 8);
    q[1][ks] = *(const bf16x8*)(Qp1 + ks * 16 + h * 8);
  }
#pragma unroll
  for (int hq = 0; hq < 2; ++hq)
#pragma unroll
    for (int mv = 0; mv < 2; ++mv)
#pragma unroll
      for (int i = 0; i < 16; ++i) o[hq][mv][i] = 0.f;
  float m_run[2] = {-INFINITY, -INFINITY}, l_run[2] = {0.f, 0.f};
  const int lr = tid >> 3, lc = tid & 7;
  const int wsw = lr * 128 + ((lc ^ ((lr >> 1) & 7)) << 4);
  u32x4 rk, rv;
  auto gload = [&](int ti) {
    const size_t key0 = (size_t)ti * 64;
    rk = *(const u32x4*)(Kb + (key0 + lr) * ldk + lc * 8);
    rv = *(const u32x4*)(Vt + (size_t)lr * S + key0 + lc * 8);
  };
  auto swrite = [&](int st) {
    char* ks_ = lds + st * ATT_STAGE;
    *(u32x4*)(ks_ + wsw) = rk;
    *(u32x4*)(ks_ + 8192 + wsw) = rv;
  };
  const int pr = (r & 0x13) | ((r & 4) << 1) | ((r & 8) >> 1);
  const int ksw = (pr >> 1) & 7;
  const int vsw = (r >> 1) & 7;
  __syncthreads();
  gload(0);
  swrite(0);
  if (ntiles > 1) gload(1);
  __syncthreads();
  for (int ti = 0; ti < ntiles; ++ti) {
    if (ti + 1 < ntiles) {
      swrite((ti + 1) & 1);
      if (ti + 2 < ntiles) gload(ti + 2);
    }
    const char* st = lds + (ti & 1) * ATT_STAGE;
    f32x16 s[2][2];
#pragma unroll
    for (int hq = 0; hq < 2; ++hq)
#pragma unroll
      for (int kb = 0; kb < 2; ++kb)
#pragma unroll
        for (int i = 0; i < 16; ++i) s[hq][kb][i] = 0.f;
    {
      bf16x8 ka[4], kb_[4];
#pragma unroll
      for (int ks = 0; ks < 4; ++ks) {
        const int co = ((2 * ks + h) ^ ksw) << 4;
        ka[ks] = *(const bf16x8*)(st + pr * 128 + co);
        kb_[ks] = *(const bf16x8*)(st + (32 + pr) * 128 + co);
      }
      asm volatile("" ::: "memory");
#pragma unroll
      for (int ks = 0; ks < 4; ++ks) {
        s[0][0] = MFMA(ka[ks], q[0][ks], s[0][0]);
        s[0][1] = MFMA(kb_[ks], q[0][ks], s[0][1]);
        s[1][0] = MFMA(ka[ks], q[1][ks], s[1][0]);
        s[1][1] = MFMA(kb_[ks], q[1][ks], s[1][1]);
      }
    }
    bf16x8 pf[2][2][2];
#pragma unroll
    for (int hq = 0; hq < 2; ++hq) {
      float t[32];
#pragma unroll
      for (int i = 0; i < 16; ++i) { t[i] = s[hq][0][i]; t[16 + i] = s[hq][1][i]; }
      float mx = t[0];
#pragma unroll
      for (int e = 1; e < 32; ++e) mx = fmaxf(mx, t[e]);
      {
        typedef __attribute__((ext_vector_type(2))) unsigned u2x_;
        const unsigned mu_ = __float_as_uint(mx);
        const u2x_ sw_ = __builtin_amdgcn_permlane32_swap(mu_, mu_, false, false);
        mx = fmaxf(__uint_as_float(sw_.x), __uint_as_float(sw_.y));
      }
      if (__builtin_amdgcn_ballot_w64(mx > m_run[hq] + 8.f) != 0ull) {
        const float m_new = fmaxf(m_run[hq], mx);
        const float alpha = fexp2(m_run[hq] - m_new);
        l_run[hq] *= alpha;
        m_run[hq] = m_new;
#pragma unroll
        for (int mv = 0; mv < 2; ++mv)
#pragma unroll
          for (int i = 0; i < 16; ++i) o[hq][mv][i] *= alpha;
      }
      float ls = 0.f;
#pragma unroll
      for (int e = 0; e < 32; ++e) { t[e] = fexp2(t[e] - m_run[hq]); ls += t[e]; }
      l_run[hq] += ls;
#pragma unroll
      for (int kb = 0; kb < 2; ++kb)
#pragma unroll
        for (int c2 = 0; c2 < 2; ++c2) {
          const int e0 = kb * 16 + c2 * 8;
          u32x4 pw = {pk_bf16(t[e0], t[e0 + 1]), pk_bf16(t[e0 + 2], t[e0 + 3]), pk_bf16(t[e0 + 4], t[e0 + 5]), pk_bf16(t[e0 + 6], t[e0 + 7])};
          pf[hq][kb][c2] = __builtin_bit_cast(bf16x8, pw);
        }
    }
    bf16x8 vf[2][2][2];
#pragma unroll
    for (int kb = 0; kb < 2; ++kb)
#pragma unroll
      for (int c2 = 0; c2 < 2; ++c2) {
        const int co = ((4 * kb + 2 * c2 + h) ^ vsw) << 4;
#pragma unroll
        for (int mv = 0; mv < 2; ++mv) vf[kb][c2][mv] = *(const bf16x8*)(st + 8192 + (mv * 32 + r) * 128 + co);
      }
    asm volatile("" ::: "memory");
#pragma unroll
    for (int kb = 0; kb < 2; ++kb)
#pragma unroll
      for (int c2 = 0; c2 < 2; ++c2)
#pragma unroll
        for (int mv = 0; mv < 2; ++mv) {
          o[0][mv] = MFMA(vf[kb][c2][mv], pf[0][kb][c2], o[0][mv]);
          o[1][mv] = MFMA(vf[kb][c2][mv], pf[1][kb][c2], o[1][mv]);
        }
    __syncthreads();
  }
#pragma unroll
  for (int hq = 0; hq < 2; ++hq) {
    const float lt = l_run[hq] + __shfl_xor(l_run[hq], 32);
    const float inv = 1.f / lt;
#pragma unroll
    for (int mv = 0; mv < 2; ++mv)
#pragma unroll
      for (int i = 0; i < 16; ++i) o[hq][mv][i] *= inv;
  }
}

DI void flash_pass_na(f32x16 (&o)[2], const u16* __restrict__ Qp, const u16* __restrict__ Kb, int ldk,
                      const u16* __restrict__ Vt, int S, int tile0, int ntiles, char* lds, int wlo, int whi,
                      const float* bias_lds, int qrow, int rs_q, int qcol, int cs0) {
  const int tid = opaque_tid(), lane = tid & 63;
  const int h = lane >> 5, r = lane & 31;
  bf16x8 q[4];
#pragma unroll
  for (int ks = 0; ks < 4; ++ks) q[ks] = *(const bf16x8*)(Qp + ks * 16 + h * 8);
#pragma unroll
  for (int mv = 0; mv < 2; ++mv)
#pragma unroll
    for (int i = 0; i < 16; ++i) o[mv][i] = 0.f;
  float m_run = -1e30f, l_run = 0.f;
  const int lr = tid >> 3, lc = tid & 7;
  const int wsw = lr * 128 + ((lc ^ ((lr >> 1) & 7)) << 4);
  u32x4 rk, rv;
  auto gload = [&](int ti) {
    const size_t key0 = (size_t)(tile0 + ti) * 64;
    rk = *(const u32x4*)(Kb + (key0 + lr) * ldk + lc * 8);
    rv = *(const u32x4*)(Vt + (size_t)lr * S + key0 + lc * 8);
  };
  auto swrite = [&](int st) {
    char* ks_ = lds + st * ATT_STAGE;
    *(u32x4*)(ks_ + wsw) = rk;
    *(u32x4*)(ks_ + 8192 + wsw) = rv;
  };
  const int pr = (r & 0x13) | ((r & 4) << 1) | ((r & 8) >> 1);
  const int krow = cs0 + pr;
  const int ksw = (krow >> 1) & 7;
  const int vsw = (r >> 1) & 7;
  const int vch0 = cs0 >> 3;
  const int csq = min(max(qcol - 8, 0), 48);
  bool navalid[16];
#pragma unroll
  for (int i = 0; i < 16; ++i) {
    const int j = i >> 2;
    const int kc = cs0 + 16 * (j >> 1) + 8 * h + 4 * (j & 1) + (i & 3);
    navalid[i] = (unsigned)(kc - csq) < 16u;
  }
  const int dcb = cs0 + 8 * h - qcol + 15;
  __syncthreads();
  gload(0);
  swrite(0);
  if (ntiles > 1) gload(1);
  __syncthreads();
  for (int ti = 0; ti < ntiles; ++ti) {
    if (ti + 1 < ntiles) {
      swrite((ti + 1) & 1);
      if (ti + 2 < ntiles) gload(ti + 2);
    }
    const char* st = lds + (ti & 1) * ATT_STAGE;
    const int kr = tile0 + ti;
    if (kr >= wlo && kr <= whi) {
      f32x16 s0;
#pragma unroll
      for (int i = 0; i < 16; ++i) s0[i] = 0.f;
      {
        bf16x8 ka[4];
#pragma unroll
        for (int ks = 0; ks < 4; ++ks) ka[ks] = *(const bf16x8*)(st + krow * 128 + (((2 * ks + h) ^ ksw) << 4));
        asm volatile("" ::: "memory");
#pragma unroll
        for (int ks = 0; ks < 4; ++ks) s0 = MFMA(ka[ks], q[ks], s0);
      }
      bf16x8 vf[2][2];
#pragma unroll
      for (int c2 = 0; c2 < 2; ++c2) {
        const int co = ((vch0 + 2 * c2 + h) ^ vsw) << 4;
#pragma unroll
        for (int mv = 0; mv < 2; ++mv) vf[c2][mv] = *(const bf16x8*)(st + 8192 + (mv * 32 + r) * 128 + co);
      }
      asm volatile("" ::: "memory");
      const bool rowok = (kr >= rs_q) && (kr <= rs_q + 7);
      const int bidx = rowok ? ((kr - qrow + 7) * 31 + dcb) : 64;
      float t[16];
#pragma unroll
      for (int i = 0; i < 16; ++i) {
        const int j = i >> 2;
        const int kco = 16 * (j >> 1) + 4 * (j & 1) + (i & 3);
        const bool ok = navalid[i] && rowok;
        const float bv = bias_lds[ok ? (bidx + kco) : 0];
        t[i] = ok ? (s0[i] + bv) : -INFINITY;
      }
      float mx = t[0];
#pragma unroll
      for (int e = 1; e < 16; ++e) mx = fmaxf(mx, t[e]);
      {
        typedef __attribute__((ext_vector_type(2))) unsigned u2x_;
        const unsigned mu_ = __float_as_uint(mx);
        const u2x_ sw_ = __builtin_amdgcn_permlane32_swap(mu_, mu_, false, false);
        mx = fmaxf(__uint_as_float(sw_.x), __uint_as_float(sw_.y));
      }
      if (__builtin_amdgcn_ballot_w64(mx > m_run + 8.f) != 0ull) {
        const float m_new = fmaxf(m_run, mx);
        const float alpha = fexp2(m_run - m_new);
        l_run *= alpha;
        m_run = m_new;
#pragma unroll
        for (int mv = 0; mv < 2; ++mv)
#pragma unroll
          for (int i = 0; i < 16; ++i) o[mv][i] *= alpha;
      }
      float ls = 0.f;
#pragma unroll
      for (int e = 0; e < 16; ++e) { t[e] = fexp2(t[e] - m_run); ls += t[e]; }
      l_run += ls;
#pragma unroll
      for (int c2 = 0; c2 < 2; ++c2) {
        const int e0 = c2 * 8;
        u32x4 pw = {pk_bf16(t[e0], t[e0 + 1]), pk_bf16(t[e0 + 2], t[e0 + 3]), pk_bf16(t[e0 + 4], t[e0 + 5]), pk_bf16(t[e0 + 6], t[e0 + 7])};
        const bf16x8 pf = __builtin_bit_cast(bf16x8, pw);
#pragma unroll
        for (int mv = 0; mv < 2; ++mv) o[mv] = MFMA(vf[c2][mv], pf, o[mv]);
      }
    }
    __syncthreads();
  }
  const float lt = l_run + __shfl_xor(l_run, 32);
  const float inv = 1.f / lt;
#pragma unroll
  for (int mv = 0; mv < 2; ++mv)
#pragma unroll
    for (int i = 0; i < 16; ++i) o[mv][i] *= inv;
}

DI void phase_attn0(const Params& p, char* lds) {
  const int tid = opaque_tid(), lane = tid & 63, w = tid >> 6;
  const int h = lane >> 5, r = lane & 31;
  const u16* QK = (const u16*)(p.ws + OFF_BIG);
  const u16* VT = (const u16*)(p.ws + OFF_VT0);
  u16* O = (u16*)(p.ws + OFF_H);
  float* stash = (float*)(p.ws + OFF_STASH) + (((size_t)blockIdx.x * 8 + w) * 64 + lane) * 64;
  float lam;
  {
    const float* lf = p.diff_lambda;
    float a = lf[lane] * lf[64 + lane];
    float b = lf[128 + lane] * lf[192 + lane];
#pragma unroll
    for (int o_ = 1; o_ < 64; o_ <<= 1) { a += __shfl_xor(a, o_); b += __shfl_xor(b, o_); }
    lam = __expf(a) - __expf(b) + 0.2f;
  }
  const int total = 1536;
  const int G = gridDim.x;
  const bool dyn = ((G & 7) == 0);
  unsigned* qhead = (unsigned*)(p.ws + OFF_BAR + 256 * (1 + (blockIdx.x & 7)));
  volatile int* qslot = (volatile int*)(lds + 2 * ATT_STAGE + 4096);
  for (int it0 = 0;; ++it0) {
    int lt;
    if (dyn) {
      __syncthreads();
      if (tid == 0) *qslot = (int)__hip_atomic_fetch_add(qhead, 1u, __ATOMIC_RELAXED, __HIP_MEMORY_SCOPE_AGENT);
      __syncthreads();
      const int k = *qslot;
      const int per = G >> 3;
      const int it = k / per;
      if (it * G >= total) break;
      lt = it * G + (blockIdx.x & 7) * per + (k - it * per);
    } else {
      if (it0 * G >= total) break;
      lt = it0 * G + blockIdx.x;
    }
    if (lt >= total) continue;
    int cls, bb, head, qb, S, tokbase;
    if (lt < 512) { cls = 0; bb = lt >> 8; head = (lt >> 6) & 3; qb = lt & 63; }
    else if (lt < 1024) { int u = lt - 512; cls = 1; bb = u >> 8; head = (u >> 6) & 3; qb = u & 63; }
    else if (lt < 1280) { int u = lt - 1024; cls = 0; bb = 2 + (u >> 5); head = (u >> 3) & 3; qb = u & 7; }
    else { int u = lt - 1280; cls = 1; bb = 2 + (u >> 5); head = (u >> 3) & 3; qb = u & 7; }
    if (bb < 2) { S = SP; tokbase = bb * SP; } else { S = SS; tokbase = NTOK_P + (bb - 2) * SS; }
    const int tq = tokbase + qb * 256 + w * 32 + r;
    const u16* Kseq = QK + (size_t)tokbase * QK0_LD;
    const u16* Vseq = VT + (size_t)640 * tokbase;
    if (cls == 0) {
      f32x16 o[4];
#pragma unroll 1
      for (int comp = 0; comp < 2; ++comp) {
        const int hc = head * 2 + comp;
        flash_pass<128, false>(o, QK + (size_t)tq * QK0_LD + hc * 64, Kseq + 512 + hc * 64, QK0_LD,
                               Vseq + (size_t)(head * 128) * S, S, 0, S >> 6, lds, QK_SCALE_LOG2, 0, 0, nullptr, 0, 0);
        if (comp == 0) {
#pragma unroll
          for (int mv = 0; mv < 4; ++mv) {
#pragma unroll
            for (int i = 0; i < 4; ++i) {
              float4 v4 = {o[mv][4 * i], o[mv][4 * i + 1], o[mv][4 * i + 2], o[mv][4 * i + 3]};
              *(float4*)(stash + mv * 16 + i * 4) = v4;
            }
            asm volatile("" ::: "memory");
          }
        }
      }
      float ss = 0.f;
#pragma unroll
      for (int mv = 0; mv < 4; ++mv) {
#pragma unroll
        for (int i = 0; i < 4; ++i) {
          const float4 s4 = *(const float4*)(stash + mv * 16 + i * 4);
          float v;
          v = s4.x - lam * o[mv][4 * i]; o[mv][4 * i] = v; ss += v * v;
          v = s4.y - lam * o[mv][4 * i + 1]; o[mv][4 * i + 1] = v; ss += v * v;
          v = s4.z - lam * o[mv][4 * i + 2]; o[mv][4 * i + 2] = v; ss += v * v;
          v = s4.w - lam * o[mv][4 * i + 3]; o[mv][4 * i + 3] = v; ss += v * v;
        }
        asm volatile("" ::: "memory");
      }
      ss += __shfl_xor(ss, 32);
      const float rs = rsqrtf(ss * (1.f / 128.f) + 1e-5f) * 0.8f;
      u16* orow = O + (size_t)tq * DM + head * 128;
#pragma unroll
      for (int mv = 0; mv < 4; ++mv) {
#pragma unroll
        for (int jp = 0; jp < 2; ++jp) {
          u32x2 XY[2];
#pragma unroll
          for (int jj = 0; jj < 2; ++jj) {
            const int j = 2 * jp + jj;
            const float4 g = *(const float4*)(p.diff_subln_g + mv * 32 + 8 * j + 4 * h);
            XY[jj] = (u32x2){pk_bf16(o[mv][4 * j] * rs * g.x, o[mv][4 * j + 1] * rs * g.y),
                             pk_bf16(o[mv][4 * j + 2] * rs * g.z, o[mv][4 * j + 3] * rs * g.w)};
          }
          half_swap(XY[0], XY[1]);
          u32x4 v = {XY[0].x, XY[0].y, XY[1].x, XY[1].y};
          *(u32x4*)(orow + mv * 32 + 16 * jp + 8 * h) = v;
        }
        asm volatile("" ::: "memory");
      }
    } else {
      f32x16 o[2][2];
      const int kvh = head >> 1;
      const u16* qrow = QK + (size_t)tq * QK0_LD + 1024 + (2 * head) * 64;
      flash_pass_q2(o, qrow, qrow + 64, Kseq + 1536 + kvh * 64, QK0_LD, Vseq + (size_t)(512 + kvh * 64) * S, S, S >> 6, lds);
#pragma unroll
      for (int hq = 0; hq < 2; ++hq) {
        u16* orow = O + (size_t)tq * DM + 512 + (2 * head + hq) * 64;
#pragma unroll
        for (int mv = 0; mv < 2; ++mv)
#pragma unroll
          for (int jp = 0; jp < 2; ++jp) {
            u32x2 X = {pk_bf16(o[hq][mv][8 * jp], o[hq][mv][8 * jp + 1]), pk_bf16(o[hq][mv][8 * jp + 2], o[hq][mv][8 * jp + 3])};
            u32x2 Y = {pk_bf16(o[hq][mv][8 * jp + 4], o[hq][mv][8 * jp + 5]), pk_bf16(o[hq][mv][8 * jp + 6], o[hq][mv][8 * jp + 7])};
            half_swap(X, Y);
            u32x4 v = {X.x, X.y, Y.x, Y.y};
            *(u32x4*)(orow + mv * 32 + 16 * jp + 8 * h) = v;
          }
      }
    }
  }
}

DI void phase_na(const Params& p, char* lds) {
  const int tid = opaque_tid(), lane = tid & 63, w = tid >> 6;
  const int h = lane >> 5, r = lane & 31;
  const u16* QK = (const u16*)(p.ws + OFF_BIG);
  const u16* VT = (const u16*)(p.ws + OFF_VT1);
  u16* O = (u16*)(p.ws + OFF_H);
  float* bias = (float*)(lds + 2 * ATT_STAGE);
  const int total = 3072;
  for (int it = 0; it * (int)gridDim.x < total; ++it) {
    const int lt = logical_index(it);
    if (lt >= total) continue;
    int bb, head, r4, S, tokbase, rows;
    if (lt < 2048) { bb = lt >> 10; head = (lt >> 6) & 15; r4 = lt & 63; S = SP; tokbase = bb * SP; rows = 256; }
    else { int u = lt - 2048; bb = 2 + (u >> 7); head = (u >> 3) & 15; r4 = u & 7; S = SS; tokbase = NTOK_P + (bb - 2) * SS; rows = 32; }
    __syncthreads();
    for (int e = tid; e < 465; e += NTHR) bias[e] = p.odd_rpb[head * 465 + e] * 1.4426950408889634f;
    const int rfirst = r4 * 4, rlast = r4 * 4 + 3;
    const int rs_first = min(max(rfirst - 4, 0), rows - 8);
    const int rs_last = min(max(rlast - 4, 0), rows - 8);
    const int ntiles = rs_last + 8 - rs_first;
    const int rp0 = rfirst + 2 * (w >> 2);
    const int cq = w & 3;
    const int qrow = rp0 + (r >> 4);
    const int qcol = 16 * cq + (r & 15);
    const int rs_q = min(max(qrow - 4, 0), rows - 8);
    const int wlo = min(max(rp0 - 4, 0), rows - 8);
    const int whi = min(max(rp0 + 1 - 4, 0), rows - 8) + 7;
    const int cs0 = min(max(16 * cq - 8, 0), 32);
    const int tq = tokbase + qrow * 64 + qcol;
    f32x16 o[2];
    flash_pass_na(o, QK + (size_t)tq * QK1_LD + head * 64, QK + (size_t)tokbase * QK1_LD + 1024 + head * 64, QK1_LD,
                  VT + (size_t)1024 * tokbase + (size_t)(head * 64) * S, S, rs_first, ntiles, lds,
                  wlo, whi, bias, qrow, rs_q, qcol, cs0);
    u16* orow = O + (size_t)tq * DM + head * 64;
#pragma unroll
    for (int mv = 0; mv < 2; ++mv)
#pragma unroll
      for (int jp = 0; jp < 2; ++jp) {
        u32x2 X = {pk_bf16(o[mv][8 * jp], o[mv][8 * jp + 1]), pk_bf16(o[mv][8 * jp + 2], o[mv][8 * jp + 3])};
        u32x2 Y = {pk_bf16(o[mv][8 * jp + 4], o[mv][8 * jp + 5]), pk_bf16(o[mv][8 * jp + 6], o[mv][8 * jp + 7])};
        half_swap(X, Y);
        u32x4 v = {X.x, X.y, Y.x, Y.y};
        *(u32x4*)(orow + mv * 32 + 16 * jp + 8 * h) = v;
      }
  }
}

DI void grid_barrier(unsigned* ctr, unsigned target) {
  asm volatile("s_waitcnt vmcnt(0)" ::: "memory");
  __syncthreads();
  if (threadIdx.x == 0) {
    __builtin_amdgcn_fence(__ATOMIC_RELEASE, "agent");
    asm volatile("s_waitcnt vmcnt(0)" ::: "memory");
    __hip_atomic_fetch_add(ctr, 1u, __ATOMIC_RELAXED, __HIP_MEMORY_SCOPE_AGENT);
    while (__hip_atomic_load(ctr, __ATOMIC_RELAXED, __HIP_MEMORY_SCOPE_AGENT) < target) __builtin_amdgcn_s_sleep(1);
    __builtin_amdgcn_fence(__ATOMIC_ACQUIRE, "agent");
    asm volatile("s_waitcnt vmcnt(0)" ::: "memory");
  }
  __syncthreads();
}

__global__ void __launch_bounds__(NTHR) mega(Params p, int ph0, int ph1) {
  __shared__ __attribute__((aligned(16))) char lds[LDS_BYTES];
  unsigned* bar = (unsigned*)(p.ws + OFF_BAR);
  if (ph0 == 0 && blockIdx.x == 0 && threadIdx.x < 9)
    __hip_atomic_store((unsigned*)(p.ws + OFF_BAR + 256 * threadIdx.x), 0u, __ATOMIC_RELAXED, __HIP_MEMORY_SCOPE_AGENT);
  if (ph0 == 0 && blockIdx.x == 0 && threadIdx.x >= 64 && threadIdx.x < 128) ((unsigned*)(p.ws + OFF_ZERO))[threadIdx.x - 64] = 0u;
  unsigned nbar = 0;
  for (int ph = ph0; ph < ph1; ++ph) {
    if (ph > ph0) {
      if (ph == ph0 + 1) cg::this_grid().sync();
      else { ++nbar; grid_barrier(bar, nbar * gridDim.x); }
    }
    const u16* H = (const u16*)(p.ws + OFF_H);
    u16* Hm = (u16*)(p.ws + OFF_H);
    const u16* Abuf = (const u16*)(p.ws + OFF_BIG);
    u16* Bm = (u16*)(p.ws + OFF_BIG);
    switch (ph) {
      case 0:
        for (int item = blockIdx.x; item < 6528; item += gridDim.x) phase0_item(p, item, lds);
        break;
      case 1: phase_ln(p, 0, 0, true, false, nullptr, 0, 0); break;
      case 2: { GemmArgs ga{H, DM, (const u16*)(p.ws + OFF_WT_IN), 1024, 9, 0, nullptr}; phase_gemm<EPI_INPROJ>(p, ga, lds); } break;
      case 3: phase_attn0(p, lds); break;
      case 5: phase_ln(p, 0, 1, true, false, Abuf, 0, 2048); break;
      case 6: { GemmArgs ga{H, DM, (const u16*)(p.ws + OFF_WT_UP0), 1024, 22, 0, nullptr}; phase_gemm<EPI_UP>(p, ga, lds); } break;
      case 8: phase_ln(p, 1, 0, false, false, H, 0, 5120); break;
      case 9: { GemmArgs ga{H, DM, (const u16*)(p.ws + OFF_WT_QKV), 1024, 12, 1, nullptr}; phase_gemm<EPI_QKV1>(p, ga, lds); } break;
      case 10: phase_na(p, lds); break;
      case 12: phase_ln(p, 1, 1, false, false, Abuf, 1, 2048); break;
      case 13: { GemmArgs ga{H, DM, (const u16*)(p.ws + OFF_WT_UP1), 1024, 22, 1, nullptr}; phase_gemm<EPI_UP>(p, ga, lds); } break;
      case 15: phase_ln(p, 0, 0, false, true, H, 1, 5120); break;
      case 4: case 7: case 11: case 14: {
        GemmArgs ga;
        if (ph == 4) ga = GemmArgs{H, DM, (const u16*)(p.ws + OFF_WT_OUT0), 1024, 4, 0, Bm};
        else if (ph == 7) ga = GemmArgs{Abuf, DFF, (const u16*)(p.ws + OFF_WT_DN0), 2816, 4, 0, Hm};
        else if (ph == 11) ga = GemmArgs{H, DM, (const u16*)(p.ws + OFF_WT_OUT1), 1024, 4, 1, Bm};
        else ga = GemmArgs{Abuf, DFF, (const u16*)(p.ws + OFF_WT_DN1), 2816, 4, 1, Hm};
        phase_gemm<EPI_M>(p, ga, lds);
      } break;
      default: break;
    }
  }
}

extern "C" void kernel_launch(void* const* d_in, const int* in_sizes, int n_in, void* d_out, int out_size,
                              void* d_ws, size_t ws_size, hipStream_t stream) {
  static int grid_blocks = 0;
  if (!grid_blocks) {
    int dev = 0, cus = 0, per_cu = 0;
    hipGetDevice(&dev);
    hipDeviceGetAttribute(&cus, hipDeviceAttributeMultiprocessorCount, dev);
    hipOccupancyMaxActiveBlocksPerMultiprocessor(&per_cu, mega, NTHR, 0);
    if (per_cu < 1) per_cu = 1;
    if (per_cu > 1) per_cu = 1;
    grid_blocks = cus * per_cu;
    if (grid_blocks > 256) grid_blocks = 256;
    if (grid_blocks < 1) grid_blocks = 1;
  }
  if (ws_size < WS_NEEDED) fprintf(stderr, "workspace too small: %zu < %zu\n", ws_size, (size_t)WS_NEEDED);
  Params p{};
  p.x_prompt = (const float*)d_in[0]; p.x_sample = (const float*)d_in[1];
  p.c_prompt = (const float*)d_in[2]; p.c_sample = (const float*)d_in[3];
  p.ada_w = (const float*)d_in[4]; p.ada_b = (const float*)d_in[5]; p.norm_g = (const float*)d_in[6];
  p.even_w_in = (const float*)d_in[7]; p.even_w_out = (const float*)d_in[8];
  p.diff_lambda = (const float*)d_in[9]; p.diff_subln_g = (const float*)d_in[10]; p.gqa_qk_g = (const float*)d_in[11];
  p.odd_w_qkv = (const float*)d_in[12]; p.odd_rpb = (const float*)d_in[13]; p.odd_w_out = (const float*)d_in[14];
  p.ffn_w_up = (const float*)d_in[15]; p.ffn_conv_w = (const float*)d_in[16]; p.ffn_conv_b = (const float*)d_in[17];
  p.ffn_w_down = (const float*)d_in[18]; p.final_g = (const float*)d_in[19];
  p.out = (float*)d_out;
  p.ws = (char*)d_ws;
#if ONE_LAUNCH
  int ph0 = 0, ph1 = NPHASE;
  void* args[] = {&p, &ph0, &ph1};
  hipError_t e = hipLaunchCooperativeKernel((void*)mega, dim3(grid_blocks), dim3(NTHR), args, 0, stream);
  if (e != hipSuccess) fprintf(stderr, "cooperative launch failed: %s (grid %d)\n", hipGetErrorString(e), grid_blocks);
#else
  for (int ph = 0; ph < NPHASE; ++ph) mega<<<dim3(grid_blocks), dim3(NTHR), 0, stream>>>(p, ph, ph + 1);
#endif
}
```

```cpp
#include <hip/hip_runtime.h>
#include <hip/hip_cooperative_groups.h>
#include <cstdio>
namespace cg = cooperative_groups;

typedef unsigned short u16;
typedef __attribute__((ext_vector_type(8))) short bf16x8;
typedef __attribute__((ext_vector_type(16))) float f32x16;
typedef __attribute__((ext_vector_type(4))) unsigned u32x4;
typedef __attribute__((ext_vector_type(2))) unsigned u32x2;
typedef __attribute__((ext_vector_type(2))) float f32x2;
typedef __attribute__((ext_vector_type(2))) __bf16 bf16v2;

#define DI __device__ __forceinline__
#define MFMA(a, b, c) __builtin_amdgcn_mfma_f32_32x32x16_bf16((a), (b), (c), 0, 0, 0)

#ifndef ONE_LAUNCH
#define ONE_LAUNCH 1
#endif

constexpr int NTHR = 512;
constexpr int DM = 1024;
constexpr int NTOK = 49152;
constexpr int NTOK_P = 32768;
constexpr int SP = 16384, SS = 2048;
constexpr int DFF = 2816;
constexpr int QK0_LD = 1664;
constexpr int QK1_LD = 2048;
constexpr int NPHASE = 16;

constexpr size_t OFF_WT_IN = 0;
constexpr size_t OFF_WT_OUT0 = OFF_WT_IN + (size_t)2304 * 1024 * 2;
constexpr size_t OFF_WT_UP0 = OFF_WT_OUT0 + (size_t)1024 * 1024 * 2;
constexpr size_t OFF_WT_UP1 = OFF_WT_UP0 + (size_t)5632 * 1024 * 2;
constexpr size_t OFF_WT_DN0 = OFF_WT_UP1 + (size_t)5632 * 1024 * 2;
constexpr size_t OFF_WT_DN1 = OFF_WT_DN0 + (size_t)1024 * 2816 * 2;
constexpr size_t OFF_WT_QKV = OFF_WT_DN1 + (size_t)1024 * 2816 * 2;
constexpr size_t OFF_WT_OUT1 = OFF_WT_QKV + (size_t)3072 * 1024 * 2;
constexpr size_t OFF_MOD = OFF_WT_OUT1 + (size_t)1024 * 1024 * 2;
constexpr size_t OFF_CS1 = OFF_MOD + (size_t)2 * 10 * 6144 * 4;
constexpr size_t OFF_CS2 = OFF_CS1 + (size_t)16384 * 32 * 8;
constexpr size_t OFF_H = OFF_CS2 + (size_t)16384 * 32 * 8;
constexpr size_t OFF_BIG = OFF_H + (size_t)NTOK * 1024 * 2;
constexpr size_t BIG_BYTES = (size_t)NTOK * 3072 * 2;
constexpr size_t OFF_VT0 = OFF_BIG + (size_t)NTOK * QK0_LD * 2;
constexpr size_t OFF_VT1 = OFF_BIG + (size_t)NTOK * QK1_LD * 2;
constexpr size_t OFF_STASH = OFF_BIG + BIG_BYTES;
constexpr size_t STASH_PER_BLOCK = (size_t)8 * 64 * 64 * 4;
constexpr size_t OFF_BAR = OFF_STASH + 256 * STASH_PER_BLOCK;
constexpr size_t OFF_ZERO = OFF_BAR + 4096;
constexpr size_t WS_NEEDED = OFF_ZERO + 256;

constexpr int LDS_BYTES = 133120;
constexpr float QK_SCALE_LOG2 = 0.125f * 1.4426950408889634f;

__device__ const float INV1[32] = {1.000000000e+00f, 7.498942614e-01f, 5.623413324e-01f, 4.216965139e-01f, 3.162277639e-01f, 2.371373773e-01f, 1.778279394e-01f, 1.333521307e-01f, 1.000000015e-01f, 7.498941571e-02f, 5.623413250e-02f, 4.216965288e-02f, 3.162277490e-02f, 2.371373773e-02f, 1.778279431e-02f, 1.333521493e-02f, 9.999999776e-03f, 7.498941850e-03f, 5.623413250e-03f, 4.216964822e-03f, 3.162277630e-03f, 2.371373586e-03f, 1.778279431e-03f, 1.333521446e-03f, 1.000000047e-03f, 7.498942432e-04f, 5.623413017e-04f, 4.216965172e-04f, 3.162277571e-04f, 2.371373703e-04f, 1.778279402e-04f, 1.333521504e-04f};
__device__ const float INV2[16] = {1.000000000e+00f, 5.623413324e-01f, 3.162277639e-01f, 1.778279394e-01f, 1.000000015e-01f, 5.623413250e-02f, 3.162277490e-02f, 1.778279431e-02f, 9.999999776e-03f, 5.623413250e-03f, 3.162277630e-03f, 1.778279431e-03f, 1.000000047e-03f, 5.623413017e-04f, 3.162277571e-04f, 1.778279402e-04f};

struct Params {
  const float *x_prompt, *x_sample, *c_prompt, *c_sample, *ada_w, *ada_b, *norm_g, *even_w_in, *even_w_out,
      *diff_lambda, *diff_subln_g, *gqa_qk_g, *odd_w_qkv, *odd_rpb, *odd_w_out, *ffn_w_up, *ffn_conv_w,
      *ffn_conv_b, *ffn_w_down, *final_g;
  float* out;
  char* ws;
};

DI unsigned pk_bf16(float a, float b) {
  f32x2 v = {a, b};
  bf16v2 r = __builtin_convertvector(v, bf16v2);
  return __builtin_bit_cast(unsigned, r);
}
DI u16 to_bf16(float a) { return (u16)(pk_bf16(a, 0.f) & 0xffffu); }
DI float bf16_to_f(u16 v) { return __uint_as_float(((unsigned)v) << 16); }
DI void half_swap(u32x2& X, u32x2& Y) {
  typedef __attribute__((ext_vector_type(2))) unsigned u2_;
  const u2_ a = __builtin_amdgcn_permlane32_swap(X.x, Y.x, false, false);
  const u2_ b = __builtin_amdgcn_permlane32_swap(X.y, Y.y, false, false);
  X.x = a.x; Y.x = a.y; X.y = b.x; Y.y = b.y;
}
DI int opaque_tid() { int t = threadIdx.x; asm volatile("" : "+v"(t)); return t; }
DI float fexp2(float x) { return __builtin_amdgcn_exp2f(x); }
DI int swz(int row, int chunk) { return row * 128 + ((chunk ^ ((row >> 1) & 7)) << 4); }
DI int crow(int i, int h) { return (i & 3) + 8 * (i >> 2) + 4 * h; }
DI void seq_of_token(int t, int& bb, int& tokbase, int& S) {
  if (t < NTOK_P) { bb = t >> 14; tokbase = bb << 14; S = SP; }
  else { int u = (t - NTOK_P) >> 11; bb = 2 + u; tokbase = NTOK_P + (u << 11); S = SS; }
}
DI const float* xin_row(const Params& p, int t) {
  return (t < NTOK_P) ? (p.x_prompt + (size_t)t * DM) : (p.x_sample + (size_t)(t - NTOK_P) * DM);
}
DI int logical_index(int it) {
  const int G = gridDim.x, b = blockIdx.x;
  if ((G & 7) == 0) return it * G + (b & 7) * (G >> 3) + (b >> 3);
  return it * G + b;
}

DI void phase0_item(const Params& p, int item, char* lds) {
  const int tid = opaque_tid();
  if (item < 192) {
    const int l = item / 96, jc = item % 96;
    float* cact = (float*)lds;
    float* red = (float*)(lds + 40960);
    for (int e = tid; e < 10240; e += NTHR) {
      int bb = e >> 10, k = e & 1023;
      float c = (bb < 2) ? p.c_prompt[bb * 1024 + k] : p.c_sample[(bb - 2) * 1024 + k];
      cact[e] = c / (1.f + __expf(-c));
    }
    __syncthreads();
    const int c4 = tid & 15, kg = tid >> 4;
    float4 acc[10];
#pragma unroll
    for (int b = 0; b < 10; ++b) acc[b] = (float4){0.f, 0.f, 0.f, 0.f};
    const float* w = p.ada_w + (size_t)l * 1024 * 6144 + (size_t)(kg * 32) * 6144 + jc * 64 + c4 * 4;
#pragma unroll 8
    for (int k = 0; k < 32; ++k) {
      const float4 wv = *(const float4*)(w + (size_t)k * 6144);
#pragma unroll
      for (int b = 0; b < 10; ++b) {
        const float cv = cact[b * 1024 + kg * 32 + k];
        acc[b].x += cv * wv.x; acc[b].y += cv * wv.y; acc[b].z += cv * wv.z; acc[b].w += cv * wv.w;
      }
    }
#pragma unroll
    for (int b = 0; b < 10; ++b) *(float4*)(red + (kg * 10 + b) * 64 + c4 * 4) = acc[b];
    __syncthreads();
    for (int e = tid; e < 640; e += NTHR) {
      int b = e >> 6, c = e & 63;
      float s_ = p.ada_b[l * 6144 + jc * 64 + c];
#pragma unroll 8
      for (int g = 0; g < 32; ++g) s_ += red[(g * 10 + b) * 64 + c];
      ((float*)(p.ws + OFF_MOD))[(l * 10 + b) * 6144 + jc * 64 + c] = s_;
    }
    __syncthreads();
    return;
  }
  item -= 192;
  if (item < 6080) {
    const float* src; u16* dst; int K, N, perm = 0, tl;
    if (item < 576) { src = p.even_w_in; dst = (u16*)(p.ws + OFF_WT_IN); K = 1024; N = 2304; tl = item; }
    else if (item < 832) { src = p.even_w_out; dst = (u16*)(p.ws + OFF_WT_OUT0); K = 1024; N = 1024; tl = item - 576; }
    else if (item < 2240) { src = p.ffn_w_up; dst = (u16*)(p.ws + OFF_WT_UP0); K = 1024; N = 5632; perm = 1; tl = item - 832; }
    else if (item < 3648) { src = p.ffn_w_up + (size_t)1024 * 5632; dst = (u16*)(p.ws + OFF_WT_UP1); K = 1024; N = 5632; perm = 1; tl = item - 2240; }
    else if (item < 4352) { src = p.ffn_w_down; dst = (u16*)(p.ws + OFF_WT_DN0); K = 2816; N = 1024; tl = item - 3648; }
    else if (item < 5056) { src = p.ffn_w_down + (size_t)2816 * 1024; dst = (u16*)(p.ws + OFF_WT_DN1); K = 2816; N = 1024; tl = item - 4352; }
    else if (item < 5824) { src = p.odd_w_qkv; dst = (u16*)(p.ws + OFF_WT_QKV); K = 1024; N = 3072; tl = item - 5056; }
    else { src = p.odd_w_out; dst = (u16*)(p.ws + OFF_WT_OUT1); K = 1024; N = 1024; tl = item - 5824; }
    const int ntn = N >> 6;
    const int k0 = (tl / ntn) << 6, n0 = (tl % ntn) << 6;
    float* T = (float*)lds;
    {
      const int kk = tid >> 4, n4 = tid & 15;
#pragma unroll
      for (int i = 0; i < 2; ++i) {
        const float4 v = *(const float4*)(src + (size_t)(k0 + kk + 32 * i) * N + n0 + 4 * n4);
        float* tr = T + (kk + 32 * i) * 65 + 4 * n4;
        tr[0] = v.x; tr[1] = v.y; tr[2] = v.z; tr[3] = v.w;
      }
    }
    __syncthreads();
    {
      const int nn = tid >> 3, k8 = tid & 7;
      const int n = n0 + nn;
      int row = n;
      if (perm) {
        if (n < DFF) row = ((n >> 7) << 8) + (n & 127);
        else { int n2 = n - DFF; row = ((n2 >> 7) << 8) + 128 + (n2 & 127); }
      }
      const float* tc = T + (8 * k8) * 65 + nn;
      u32x4 o4 = {pk_bf16(tc[0], tc[65]), pk_bf16(tc[130], tc[195]), pk_bf16(tc[260], tc[325]), pk_bf16(tc[390], tc[455])};
      *(u32x4*)(dst + (size_t)row * K + k0 + 8 * k8) = o4;
    }
    __syncthreads();
    return;
  }
  item -= 6080;
  {
#pragma unroll
    for (int i = 0; i < 8; ++i) {
      int e = item * 4096 + i * 512 + tid;
      int tab = e >> 19;
      int ee = e & 524287;
      int t = ee >> 5, j = ee & 31;
      float ang;
      if (tab == 0) ang = (float)t * INV1[j];
      else ang = (j < 16) ? (float)(t >> 6) * INV2[j] : (float)(t & 63) * INV2[j - 16];
      double rev = (double)ang * 0.15915494309189533577;
      double fr = rev - rint(rev);
      float f = (float)fr;
      f32x2 cs = {__builtin_amdgcn_cosf(f), __builtin_amdgcn_sinf(f)};
      ((f32x2*)(p.ws + (tab ? OFF_CS2 : OFF_CS1)))[ee] = cs;
    }
  }
}

DI void phase_ln(const Params& p, int layer, int sub, bool first, bool final_, const u16* M, int glayer, int goff) {
  const int tid = opaque_tid(), lane = tid & 63, w = tid >> 6;
  const float* gn = final_ ? p.final_g : (p.norm_g + (layer * 2 + sub) * 1024);
  const float* mod = (const float*)(p.ws + OFF_MOD);
  u16* H = (u16*)(p.ws + OFF_H);
  const int nw = gridDim.x * 8, gw = blockIdx.x * 8 + w;
  const int rows_per = (NTOK + nw - 1) / nw;
  const int r0 = gw * rows_per;
  const int r1 = (r0 + rows_per < NTOK) ? (r0 + rows_per) : NTOK;
  if (r0 >= r1) return;
  auto load_row = [&](int row, float4 (&v)[4], u32x2 (&mm)[4]) {
    const float* xr = first ? xin_row(p, row) : (p.out + (size_t)row * DM);
#pragma unroll
    for (int j = 0; j < 4; ++j) v[j] = *(const float4*)(xr + j * 256 + lane * 4);
    if (M) {
#pragma unroll
      for (int j = 0; j < 4; ++j) mm[j] = *(const u32x2*)(M + (size_t)row * DM + j * 256 + lane * 4);
    }
  };
  float4 pg[4], psh[4], pgm[4];
  int cur_bb = -1;
  float4 v[4], vn[4], vn2[4];
  u32x2 mm[4], mmn[4], mmn2[4];
#pragma unroll
  for (int j = 0; j < 4; ++j) {
    mm[j] = (u32x2){0u, 0u}; mmn[j] = (u32x2){0u, 0u}; mmn2[j] = (u32x2){0u, 0u};
    vn[j] = (float4){0.f, 0.f, 0.f, 0.f}; vn2[j] = (float4){0.f, 0.f, 0.f, 0.f};
  }
  load_row(r0, v, mm);
  if (r0 + 1 < r1) load_row(r0 + 1, vn, mmn);
  for (int row = r0; row < r1; ++row) {
    if (row + 2 < r1) load_row(row + 2, vn2, mmn2);
    int bb, tokbase, S;
    seq_of_token(row, bb, tokbase, S);
    if (bb != cur_bb) {
      cur_bb = bb;
      const float* mrow = mod + (layer * 10 + bb) * 6144 + sub * 3072;
      const float* grow = mod + (glayer * 10 + bb) * 6144 + goff;
#pragma unroll
      for (int j = 0; j < 4; ++j) {
        const int c = j * 256 + lane * 4;
        const float4 g = *(const float4*)(gn + c);
        if (final_) { pg[j] = g; psh[j] = (float4){0.f, 0.f, 0.f, 0.f}; }
        else {
          const float4 sh = *(const float4*)(mrow + c);
          const float4 sc = *(const float4*)(mrow + 1024 + c);
          pg[j] = (float4){g.x * (1.f + sc.x), g.y * (1.f + sc.y), g.z * (1.f + sc.z), g.w * (1.f + sc.w)};
          psh[j] = sh;
        }
        if (M) pgm[j] = *(const float4*)(grow + c);
      }
    }
    if (M) {
#pragma unroll
      for (int j = 0; j < 4; ++j) {
        const int c = j * 256 + lane * 4;
        v[j].x += pgm[j].x * __uint_as_float(mm[j].x << 16);
        v[j].y += pgm[j].y * __uint_as_float(mm[j].x & 0xffff0000u);
        v[j].z += pgm[j].z * __uint_as_float(mm[j].y << 16);
        v[j].w += pgm[j].w * __uint_as_float(mm[j].y & 0xffff0000u);
        if (!final_) *(float4*)(p.out + (size_t)row * DM + c) = v[j];
      }
    }
    float ss = 0.f;
#pragma unroll
    for (int j = 0; j < 4; ++j) ss += v[j].x * v[j].x + v[j].y * v[j].y + v[j].z * v[j].z + v[j].w * v[j].w;
#pragma unroll
    for (int o = 1; o < 64; o <<= 1) ss += __shfl_xor(ss, o);
    const float rstd = rsqrtf(ss * (1.f / 1024.f) + 1e-6f);
    if (final_) {
#pragma unroll
      for (int j = 0; j < 4; ++j) {
        float4 o4 = {v[j].x * rstd * pg[j].x, v[j].y * rstd * pg[j].y, v[j].z * rstd * pg[j].z, v[j].w * rstd * pg[j].w};
        *(float4*)(p.out + (size_t)row * DM + j * 256 + lane * 4) = o4;
      }
    } else {
#pragma unroll
      for (int j = 0; j < 4; ++j) {
        const int c = j * 256 + lane * 4;
        const float a0 = v[j].x * rstd * pg[j].x + psh[j].x;
        const float a1 = v[j].y * rstd * pg[j].y + psh[j].y;
        const float a2 = v[j].z * rstd * pg[j].z + psh[j].z;
        const float a3 = v[j].w * rstd * pg[j].w + psh[j].w;
        u32x2 o2 = {pk_bf16(a0, a1), pk_bf16(a2, a3)};
        *(u32x2*)(H + (size_t)row * DM + c) = o2;
      }
    }
#pragma unroll
    for (int j = 0; j < 4; ++j) { v[j] = vn[j]; mm[j] = mmn[j]; vn[j] = vn2[j]; mmn[j] = mmn2[j]; }
  }
}

template <bool SWAP>
DI void gemm_mainloop(f32x16 (&acc)[4][2], const u16* __restrict__ A, int lda, int rlo, int rhi,
                      const u16* __restrict__ B, int ldb, int K, char* lds, const u16* zero_line) {
  const int tid = opaque_tid(), lane = tid & 63, w = tid >> 6;
  const int wm = w >> 2, wn = w & 3;
  const int h = lane >> 5, r = lane & 31;
  const int lr = tid >> 3, lc = tid & 7;
#pragma unroll
  for (int mi = 0; mi < 4; ++mi)
#pragma unroll
    for (int ni = 0; ni < 2; ++ni)
#pragma unroll
      for (int i = 0; i < 16; ++i) acc[mi][ni][i] = 0.f;
  const int gch = (lc ^ ((lr >> 1) & 7)) * 8;
  const u16* ap = A + (ptrdiff_t)lr * lda + gch;
  const u16* bp = B + (ptrdiff_t)lr * ldb + gch;
  const int nk = K >> 6;
  typedef __attribute__((address_space(3))) unsigned lds_u32;
  auto glds = [&](int kt, int st) {
    char* as_ = lds + st * 65536 + tid * 16;
#pragma unroll
    for (int i = 0; i < 4; ++i) {
      const int rr = lr + 64 * i;
      const u16* srca = (rr >= rlo && rr < rhi) ? (ap + (ptrdiff_t)(64 * i) * lda + kt * 64) : (zero_line + lc * 8);
      __builtin_amdgcn_global_load_lds((const unsigned*)srca, (lds_u32*)(as_ + i * 8192), 16, 0, 0);
      __builtin_amdgcn_global_load_lds((const unsigned*)(bp + (ptrdiff_t)(64 * i) * ldb + kt * 64), (lds_u32*)(as_ + 32768 + i * 8192), 16, 0, 0);
    }
  };
  const int sw = (r >> 1) & 7;
  const int arow_off = (wm * 128 + r) * 128;
  const int brow_off = 32768 + (wn * 64 + r) * 128;
  __syncthreads();
  glds(0, 0);
  asm volatile("s_waitcnt vmcnt(0)" ::: "memory");
  __syncthreads();
  bf16x8 fa[2][4], fb[2][2];
#pragma unroll
  for (int mi = 0; mi < 4; ++mi)
#pragma unroll
    for (int e = 0; e < 8; ++e) fa[1][mi][e] = 0;
#pragma unroll
  for (int ni = 0; ni < 2; ++ni)
#pragma unroll
    for (int e = 0; e < 8; ++e) fb[1][ni][e] = 0;
  auto ldfrag = [&](const char* st, int ks, int buf) {
    const int co = ((2 * ks + h) ^ sw) << 4;
#pragma unroll
    for (int mi = 0; mi < 4; ++mi) fa[buf][mi] = *(const bf16x8*)(st + arow_off + mi * 4096 + co);
#pragma unroll
    for (int ni = 0; ni < 2; ++ni) fb[buf][ni] = *(const bf16x8*)(st + brow_off + ni * 4096 + co);
  };
  auto mma = [&](int buf) {
#pragma unroll
    for (int mi = 0; mi < 4; ++mi)
#pragma unroll
      for (int ni = 0; ni < 2; ++ni)
        acc[mi][ni] = SWAP ? MFMA(fb[buf][ni], fa[buf][mi], acc[mi][ni]) : MFMA(fa[buf][mi], fb[buf][ni], acc[mi][ni]);
  };
  auto pat_rd = [&]() {
#pragma unroll
    for (int g = 0; g < 6; ++g) {
      __builtin_amdgcn_sched_group_barrier(0x100, 1, 0);
      __builtin_amdgcn_sched_group_barrier(0x008, 1, 0);
    }
    __builtin_amdgcn_sched_group_barrier(0x008, 2, 0);
  };
  for (int kt = 0; kt < nk; ++kt) {
    const char* st = lds + (kt & 1) * 65536;
    ldfrag(st, 0, 0);
    mma(1);
    pat_rd();
    if (kt + 1 < nk) glds(kt + 1, (kt + 1) & 1);
    ldfrag(st, 1, 1);
    mma(0);
    pat_rd();
    ldfrag(st, 2, 0);
    mma(1);
    pat_rd();
    ldfrag(st, 3, 1);
    mma(0);
    pat_rd();
    asm volatile("s_waitcnt vmcnt(0)" ::: "memory");
    __syncthreads();
  }
  mma(1);
}

DI void tile_mn(int t, int Mt, int Nt, int& m, int& n) {
  const int per = 8 * Nt;
  int g = t / per;
  int rem = t - g * per;
  int gs = Mt - g * 8;
  if (gs > 8) gs = 8;
  n = rem / gs;
  m = g * 8 + (rem - n * gs);
}

enum { EPI_INPROJ = 0, EPI_M = 1, EPI_UP = 2, EPI_QKV1 = 3 };

struct GemmArgs {
  const u16* A; int lda; const u16* Bt; int K; int Nt; int layer; u16* Mout;
};

template <int EPI>
DI void phase_gemm(const Params& p, const GemmArgs& ga, char* lds) {
  const int tid = opaque_tid(), lane = tid & 63, w = tid >> 6;
  const int wm = w >> 2, wn = w & 3;
  const int h = lane >> 5, r = lane & 31;
  const int Mt = (EPI == EPI_UP) ? 194 : 192;
  const int total = Mt * ga.Nt;
  for (int it = 0; it * (int)gridDim.x < total; ++it) {
    const int lt = logical_index(it);
    if (lt >= total) continue;
    int mt, nt;
    tile_mn(lt, Mt, ga.Nt, mt, nt);
    int bb, tokbase, S, pos0, rlo = 0, rhi = 256;
    if (EPI == EPI_UP) {
      bb = 0; tokbase = 0; S = NTOK;
      pos0 = 254 * mt - 1;
      rlo = (mt == 0) ? 1 : 0;
      rhi = NTOK - pos0; if (rhi > 256) rhi = 256;
    } else {
      seq_of_token(mt * 256, bb, tokbase, S);
      pos0 = mt * 256 - tokbase;
    }
    const u16* A = ga.A + (ptrdiff_t)(tokbase + pos0) * ga.lda;
    const u16* B = ga.Bt + (size_t)(nt * 256) * ga.K;
    f32x16 acc[4][2];
    bool swap;
    if (EPI == EPI_M) swap = true;
    else if (EPI == EPI_UP) swap = true;
    else if (EPI == EPI_QKV1) swap = (nt < 8);
    else swap = !(nt == 4 || nt == 5);
    if (swap) gemm_mainloop<true>(acc, A, ga.lda, rlo, rhi, B, ga.K, ga.K, lds, (const u16*)(p.ws + OFF_ZERO));
    else gemm_mainloop<false>(acc, A, ga.lda, rlo, rhi, B, ga.K, ga.K, lds, (const u16*)(p.ws + OFF_ZERO));

    const int n0w = nt * 256 + wn * 64;
    if (EPI == EPI_M) {
      u16* mo = ga.Mout + (size_t)(tokbase + pos0 + wm * 128 + r) * DM + n0w + 8 * h;
#pragma unroll
      for (int mi = 0; mi < 4; ++mi)
#pragma unroll
        for (int ni = 0; ni < 2; ++ni)
#pragma unroll
          for (int jp = 0; jp < 2; ++jp) {
            u32x2 X = {pk_bf16(acc[mi][ni][8 * jp], acc[mi][ni][8 * jp + 1]), pk_bf16(acc[mi][ni][8 * jp + 2], acc[mi][ni][8 * jp + 3])};
            u32x2 Y = {pk_bf16(acc[mi][ni][8 * jp + 4], acc[mi][ni][8 * jp + 5]), pk_bf16(acc[mi][ni][8 * jp + 6], acc[mi][ni][8 * jp + 7])};
            half_swap(X, Y);
            u32x4 v = {X.x, X.y, Y.x, Y.y};
            *(u32x4*)(mo + (size_t)(mi * 32) * DM + ni * 32 + 16 * jp) = v;
          }
    } else if (EPI == EPI_QKV1) {
      u16* QK = (u16*)(p.ws + OFF_BIG);
      u16* VT = (u16*)(p.ws + OFF_VT1);
      if (swap) {
        const float sc = (n0w < 1024) ? QK_SCALE_LOG2 : 1.f;
        u16* qo = QK + (size_t)(tokbase + pos0 + wm * 128 + r) * QK1_LD + n0w + 8 * h;
#pragma unroll
        for (int mi = 0; mi < 4; ++mi)
#pragma unroll
          for (int ni = 0; ni < 2; ++ni)
#pragma unroll
            for (int jp = 0; jp < 2; ++jp) {
              u32x2 X = {pk_bf16(acc[mi][ni][8 * jp] * sc, acc[mi][ni][8 * jp + 1] * sc), pk_bf16(acc[mi][ni][8 * jp + 2] * sc, acc[mi][ni][8 * jp + 3] * sc)};
              u32x2 Y = {pk_bf16(acc[mi][ni][8 * jp + 4] * sc, acc[mi][ni][8 * jp + 5] * sc), pk_bf16(acc[mi][ni][8 * jp + 6] * sc, acc[mi][ni][8 * jp + 7] * sc)};
              half_swap(X, Y);
              u32x4 v = {X.x, X.y, Y.x, Y.y};
              *(u32x4*)(qo + (size_t)(mi * 32) * QK1_LD + ni * 32 + 16 * jp) = v;
            }
      } else {
#pragma unroll
        for (int ni = 0; ni < 2; ++ni) {
          const int vrow = n0w - 2048 + ni * 32 + r;
          u16* vb = VT + (size_t)1024 * tokbase + (size_t)vrow * S;
#pragma unroll
          for (int mi = 0; mi < 4; ++mi)
#pragma unroll
            for (int jp = 0; jp < 2; ++jp) {
              const int pos = pos0 + wm * 128 + mi * 32 + 16 * jp + 8 * h;
              u32x2 X = {pk_bf16(acc[mi][ni][8 * jp], acc[mi][ni][8 * jp + 1]), pk_bf16(acc[mi][ni][8 * jp + 2], acc[mi][ni][8 * jp + 3])};
              u32x2 Y = {pk_bf16(acc[mi][ni][8 * jp + 4], acc[mi][ni][8 * jp + 5]), pk_bf16(acc[mi][ni][8 * jp + 6], acc[mi][ni][8 * jp + 7])};
              half_swap(X, Y);
              u32x4 v = {X.x, X.y, Y.x, Y.y};
              *(u32x4*)(vb + pos) = v;
            }
        }
      }
    } else if (EPI == EPI_INPROJ) {
      u16* QK = (u16*)(p.ws + OFF_BIG);
      u16* VT = (u16*)(p.ws + OFF_VT0);
      if (!swap) {
#pragma unroll
        for (int ni = 0; ni < 2; ++ni) {
          const int vrow = (n0w - 1024) + ni * 32 + r;
          u16* vb = VT + (size_t)640 * tokbase + (size_t)vrow * S;
#pragma unroll
          for (int mi = 0; mi < 4; ++mi)
#pragma unroll
            for (int jp = 0; jp < 2; ++jp) {
              const int pos = pos0 + wm * 128 + mi * 32 + 16 * jp + 8 * h;
              u32x2 X = {pk_bf16(acc[mi][ni][8 * jp], acc[mi][ni][8 * jp + 1]), pk_bf16(acc[mi][ni][8 * jp + 2], acc[mi][ni][8 * jp + 3])};
              u32x2 Y = {pk_bf16(acc[mi][ni][8 * jp + 4], acc[mi][ni][8 * jp + 5]), pk_bf16(acc[mi][ni][8 * jp + 6], acc[mi][ni][8 * jp + 7])};
              half_swap(X, Y);
              u32x4 v = {X.x, X.y, Y.x, Y.y};
              *(u32x4*)(vb + pos) = v;
            }
        }
      } else if (n0w >= 2176) {
#pragma unroll
        for (int ni = 0; ni < 2; ++ni)
#pragma unroll
          for (int i = 0; i < 16; ++i) {
            const int vrow = 512 + (n0w - 2176) + ni * 32 + 8 * (i >> 2) + 4 * h + (i & 3);
            u16* vb = VT + (size_t)640 * tokbase + (size_t)vrow * S + pos0 + wm * 128 + r;
#pragma unroll
            for (int mi = 0; mi < 4; ++mi) vb[mi * 32] = to_bf16(acc[mi][ni][i]);
          }
      } else {
        const bool nrm = (n0w >= 1536);
        int dcol;
        const float* gq = p.gqa_qk_g;
        float osc = 1.f;
        if (n0w < 1024) { dcol = n0w; if (n0w < 512) osc = QK_SCALE_LOG2; }
        else if (n0w < 2048) { dcol = 1024 + (n0w - 1536); osc = QK_SCALE_LOG2; }
        else { dcol = 1536 + (n0w - 2048); gq += 64; }
        const float* cs = (const float*)(p.ws + (nrm ? OFF_CS2 : OFF_CS1));
#pragma unroll
        for (int mi = 0; mi < 4; ++mi) {
          const int pos = pos0 + wm * 128 + mi * 32 + r;
          float rs = 1.f;
          if (nrm) {
            float ss = 0.f;
#pragma unroll
            for (int i = 0; i < 16; ++i) ss += acc[mi][0][i] * acc[mi][0][i] + acc[mi][1][i] * acc[mi][1][i];
            ss += __shfl_xor(ss, 32);
            rs = rsqrtf(ss * (1.f / 64.f) + 1e-6f);
          }
          u16* q = QK + (size_t)(tokbase + pos) * QK0_LD + dcol + 8 * h;
          const float* csr = cs + (size_t)pos * 64 + 8 * h;
#pragma unroll
          for (int jp = 0; jp < 2; ++jp) {
            u32x2 v1[2], v2[2];
#pragma unroll
            for (int jj = 0; jj < 2; ++jj) {
              const int j = 2 * jp + jj;
              const float4 ca = *(const float4*)(csr + 16 * j);
              const float4 cb = *(const float4*)(csr + 16 * j + 4);
              float x1[4], x2[4];
#pragma unroll
              for (int e = 0; e < 4; ++e) { x1[e] = acc[mi][0][4 * j + e]; x2[e] = acc[mi][1][4 * j + e]; }
              if (nrm) {
                const float4 ga_ = *(const float4*)(gq + 8 * j + 4 * h);
                const float4 gb_ = *(const float4*)(gq + 32 + 8 * j + 4 * h);
                x1[0] *= rs * ga_.x; x1[1] *= rs * ga_.y; x1[2] *= rs * ga_.z; x1[3] *= rs * ga_.w;
                x2[0] *= rs * gb_.x; x2[1] *= rs * gb_.y; x2[2] *= rs * gb_.z; x2[3] *= rs * gb_.w;
              }
              const float cc[4] = {ca.x, ca.z, cb.x, cb.z};
              const float sn[4] = {ca.y, ca.w, cb.y, cb.w};
              float y1[4], y2[4];
#pragma unroll
              for (int e = 0; e < 4; ++e) {
                y1[e] = (x1[e] * cc[e] - x2[e] * sn[e]) * osc;
                y2[e] = (x2[e] * cc[e] + x1[e] * sn[e]) * osc;
              }
              v1[jj] = (u32x2){pk_bf16(y1[0], y1[1]), pk_bf16(y1[2], y1[3])};
              v2[jj] = (u32x2){pk_bf16(y2[0], y2[1]), pk_bf16(y2[2], y2[3])};
            }
            half_swap(v1[0], v1[1]);
            half_swap(v2[0], v2[1]);
            u32x4 w1 = {v1[0].x, v1[0].y, v1[1].x, v1[1].y};
            u32x4 w2 = {v2[0].x, v2[0].y, v2[1].x, v2[1].y};
            *(u32x4*)(q + 16 * jp) = w1;
            *(u32x4*)(q + 32 + 16 * jp) = w2;
          }
        }
      }
    } else {
      __syncthreads();
      constexpr int RS = 520;
      {
        char* wbase = lds + (wm * 128 + r) * RS + (wn * 64 + 4 * h) * 2;
#pragma unroll
        for (int mi = 0; mi < 4; ++mi)
#pragma unroll
          for (int ni = 0; ni < 2; ++ni)
#pragma unroll
            for (int j = 0; j < 4; ++j) {
              u32x2 v = {pk_bf16(acc[mi][ni][4 * j], acc[mi][ni][4 * j + 1]), pk_bf16(acc[mi][ni][4 * j + 2], acc[mi][ni][4 * j + 3])};
              *(u32x2*)(wbase + mi * 32 * RS + (ni * 32 + 8 * j) * 2) = v;
            }
      }
      __syncthreads();
      {
        const int q4 = tid & 31, seg = tid >> 5;
        const int ch = nt * 128 + 4 * q4;
        const float* cw = p.ffn_conv_w + (size_t)ga.layer * 3 * 5632;
        const float* cb = p.ffn_conv_b + (size_t)ga.layer * 5632;
        float4 wg[3], wv[3];
#pragma unroll
        for (int t3 = 0; t3 < 3; ++t3) { wg[t3] = *(const float4*)(cw + t3 * 5632 + ch); wv[t3] = *(const float4*)(cw + t3 * 5632 + DFF + ch); }
        const float4 bg = *(const float4*)(cb + ch);
        const float4 bv = *(const float4*)(cb + DFF + ch);
        const char* gbase = lds + q4 * 8;
        const char* vbase = lds + 256 + q4 * 8;
        const int R0 = 1 + seg * 16;
        const int Rend = (R0 + 16 < 255) ? (R0 + 16) : 255;
        auto ld4 = [&](const char* b_, int R) -> float4 {
          const u32x2 u = *(const u32x2*)(b_ + R * RS);
          float4 f = {__uint_as_float(u.x << 16), __uint_as_float(u.x & 0xffff0000u), __uint_as_float(u.y << 16), __uint_as_float(u.y & 0xffff0000u)};
          return f;
        };
        float4 pg = ld4(gbase, R0 - 1), pvv = ld4(vbase, R0 - 1);
        float4 cg_ = ld4(gbase, R0), cv_ = ld4(vbase, R0);
        u16* Aout = (u16*)(p.ws + OFF_BIG) + (ptrdiff_t)(tokbase + pos0) * DFF + ch;
#pragma unroll 4
        for (int R = R0; R < Rend; ++R) {
          const float4 ng = ld4(gbase, R + 1), nv = ld4(vbase, R + 1);
          if (pos0 + R < S) {
            const int tflat = pos0 + R;
            const int ps = (tflat < NTOK_P) ? (tflat & (SP - 1)) : ((tflat - NTOK_P) & (SS - 1));
            const int Ss = (tflat < NTOK_P) ? SP : SS;
            const float mp = (ps == 0) ? 0.f : 1.f;
            const float mn = (ps == Ss - 1) ? 0.f : 1.f;
            float g[4], v[4];
            g[0] = mp * pg.x * wg[0].x + cg_.x * wg[1].x + mn * ng.x * wg[2].x + bg.x;
            g[1] = mp * pg.y * wg[0].y + cg_.y * wg[1].y + mn * ng.y * wg[2].y + bg.y;
            g[2] = mp * pg.z * wg[0].z + cg_.z * wg[1].z + mn * ng.z * wg[2].z + bg.z;
            g[3] = mp * pg.w * wg[0].w + cg_.w * wg[1].w + mn * ng.w * wg[2].w + bg.w;
            v[0] = mp * pvv.x * wv[0].x + cv_.x * wv[1].x + mn * nv.x * wv[2].x + bv.x;
            v[1] = mp * pvv.y * wv[0].y + cv_.y * wv[1].y + mn * nv.y * wv[2].y + bv.y;
            v[2] = mp * pvv.z * wv[0].z + cv_.z * wv[1].z + mn * nv.z * wv[2].z + bv.z;
            v[3] = mp * pvv.w * wv[0].w + cv_.w * wv[1].w + mn * nv.w * wv[2].w + bv.w;
            float a_[4];
#pragma unroll
            for (int e = 0; e < 4; ++e) a_[e] = g[e] * __builtin_amdgcn_rcpf(1.f + fexp2(-1.4426950408889634f * g[e])) * v[e];
            u32x2 ov = {pk_bf16(a_[0], a_[1]), pk_bf16(a_[2], a_[3])};
            *(u32x2*)(Aout + (ptrdiff_t)R * DFF) = ov;
          }
          pg = cg_; pvv = cv_; cg_ = ng; cv_ = nv;
        }
      }
    }
  }
}

constexpr int ATT_STAGE = 24576;
template <int DV, bool NA>
DI void flash_pass(f32x16 (&o)[DV / 32], const u16* __restrict__ Qp, const u16* __restrict__ Kb, int ldk,
                   const u16* __restrict__ Vt, int S, int tile0, int ntiles, char* lds, float cscale,
                   int wlo, int whi, const float* bias_lds, int r_w, int qc) {
  const int tid = opaque_tid(), lane = tid & 63;
  const int h = lane >> 5, r = lane & 31;
  bf16x8 q[4];
#pragma unroll
  for (int ks = 0; ks < 4; ++ks) q[ks] = *(const bf16x8*)(Qp + ks * 16 + h * 8);
#pragma unroll
  for (int mv = 0; mv < DV / 32; ++mv)
#pragma unroll
    for (int i = 0; i < 16; ++i) o[mv][i] = 0.f;
  float m_run = -INFINITY, l_run = 0.f;
  const int lr = tid >> 3, lc = tid & 7;
  const int wsw = lr * 128 + ((lc ^ ((lr >> 1) & 7)) << 4);
  u32x4 rk, rv[DV / 64];
  auto gload = [&](int ti) {
    const size_t key0 = (size_t)(tile0 + ti) * 64;
    rk = *(const u32x4*)(Kb + (key0 + lr) * ldk + lc * 8);
#pragma unroll
    for (int i = 0; i < DV / 64; ++i) rv[i] = *(const u32x4*)(Vt + (size_t)(lr + 64 * i) * S + key0 + lc * 8);
  };
  auto swrite = [&](int st) {
    char* ks_ = lds + st * ATT_STAGE;
    *(u32x4*)(ks_ + wsw) = rk;
#pragma unroll
    for (int i = 0; i < DV / 64; ++i) *(u32x4*)(ks_ + 8192 + i * 8192 + wsw) = rv[i];
  };
  const int pr = (r & 0x13) | ((r & 4) << 1) | ((r & 8) >> 1);
  const int ksw = (pr >> 1) & 7;
  const int vsw = (r >> 1) & 7;
  const int cs_ = NA ? min(max(qc - 8, 0), 48) : 0;
  __syncthreads();
  gload(0);
  swrite(0);
  if (ntiles > 1) gload(1);
  __syncthreads();
  for (int ti = 0; ti < ntiles; ++ti) {
    if (ti + 1 < ntiles) {
      swrite((ti + 1) & 1);
      if (ti + 2 < ntiles) gload(ti + 2);
    }
    const char* st = lds + (ti & 1) * ATT_STAGE;
    const bool active = !NA || ((tile0 + ti) >= wlo && (tile0 + ti) <= whi);
    if (active) {
      f32x16 s0, s1;
#pragma unroll
      for (int i = 0; i < 16; ++i) { s0[i] = 0.f; s1[i] = 0.f; }
      {
        bf16x8 ka[4], kb_[4];
#pragma unroll
        for (int ks = 0; ks < 4; ++ks) {
          const int co = ((2 * ks + h) ^ ksw) << 4;
          ka[ks] = *(const bf16x8*)(st + pr * 128 + co);
          kb_[ks] = *(const bf16x8*)(st + (32 + pr) * 128 + co);
        }
        asm volatile("" ::: "memory");
#pragma unroll
        for (int ks = 0; ks < 4; ++ks) {
          s0 = MFMA(ka[ks], q[ks], s0);
          s1 = MFMA(kb_[ks], q[ks], s1);
        }
      }
      bf16x8 vf0[2][DV / 32];
#pragma unroll
      for (int c2 = 0; c2 < 2; ++c2) {
        const int co = ((2 * c2 + h) ^ vsw) << 4;
#pragma unroll
        for (int mv = 0; mv < DV / 32; ++mv) vf0[c2][mv] = *(const bf16x8*)(st + 8192 + (mv * 32 + r) * 128 + co);
      }
      asm volatile("" ::: "memory");
      float t[32];
#pragma unroll
      for (int i = 0; i < 16; ++i) { t[i] = s0[i]; t[16 + i] = s1[i]; }
      if (NA) {
        const int kr = tile0 + ti;
        const int brow = (kr - r_w + 7) * 31;
#pragma unroll
        for (int e = 0; e < 32; ++e) {
          const int i = e & 15, j = i >> 2;
          const int kc = (e >> 4) * 32 + 16 * (j >> 1) + 8 * h + 4 * (j & 1) + (i & 3);
          const bool valid = (kc >= cs_) && (kc < cs_ + 16);
          const int bi = valid ? (brow + kc - qc + 15) : 0;
          const float bv = bias_lds[bi];
          t[e] = valid ? (t[e] + bv) : -INFINITY;
        }
      }
      float mx = t[0];
#pragma unroll
      for (int e = 1; e < 32; ++e) mx = fmaxf(mx, t[e]);
      mx = fmaxf(mx, __shfl_xor(mx, 32));
      if (__builtin_amdgcn_ballot_w64(mx > m_run + 8.f) != 0ull) {
        const float m_new = fmaxf(m_run, mx);
        const float alpha = fexp2(m_run - m_new);
        l_run *= alpha;
        m_run = m_new;
#pragma unroll
        for (int mv = 0; mv < DV / 32; ++mv)
#pragma unroll
          for (int i = 0; i < 16; ++i) o[mv][i] *= alpha;
      }
      float ls = 0.f;
#pragma unroll
      for (int e = 0; e < 32; ++e) { t[e] = fexp2(t[e] - m_run); ls += t[e]; }
      l_run += ls;
      bf16x8 pf[2][2];
#pragma unroll
      for (int kb = 0; kb < 2; ++kb)
#pragma unroll
        for (int c2 = 0; c2 < 2; ++c2) {
          const int e0 = kb * 16 + c2 * 8;
          u32x4 pw = {pk_bf16(t[e0], t[e0 + 1]), pk_bf16(t[e0 + 2], t[e0 + 3]), pk_bf16(t[e0 + 4], t[e0 + 5]), pk_bf16(t[e0 + 6], t[e0 + 7])};
          pf[kb][c2] = __builtin_bit_cast(bf16x8, pw);
        }
      bf16x8 vf1[2][DV / 32];
#pragma unroll
      for (int c2 = 0; c2 < 2; ++c2) {
        const int co = ((4 + 2 * c2 + h) ^ vsw) << 4;
#pragma unroll
        for (int mv = 0; mv < DV / 32; ++mv) vf1[c2][mv] = *(const bf16x8*)(st + 8192 + (mv * 32 + r) * 128 + co);
      }
      asm volatile("" ::: "memory");
#pragma unroll
      for (int c2 = 0; c2 < 2; ++c2)
#pragma unroll
        for (int mv = 0; mv < DV / 32; ++mv) o[mv] = MFMA(vf0[c2][mv], pf[0][c2], o[mv]);
#pragma unroll
      for (int c2 = 0; c2 < 2; ++c2)
#pragma unroll
        for (int mv = 0; mv < DV / 32; ++mv) o[mv] = MFMA(vf1[c2][mv], pf[1][c2], o[mv]);
    }
    __syncthreads();
  }
  const float lt = l_run + __shfl_xor(l_run, 32);
  const float inv = 1.f / lt;
#pragma unroll
  for (int mv = 0; mv < DV / 32; ++mv)
#pragma unroll
    for (int i = 0; i < 16; ++i) o[mv][i] *= inv;
}


DI void flash_pass_q2(f32x16 (&o)[2][2], const u16* __restrict__ Qp0, const u16* __restrict__ Qp1,
                      const u16* __restrict__ Kb, int ldk, const u16* __restrict__ Vt, int S, int ntiles, char* lds) {
  const int tid = opaque_tid(), lane = tid & 63;
  const int h = lane >> 5, r = lane & 31;
  bf16x8 q[2][4];
#pragma unroll
  for (int ks = 0; ks < 4; ++ks) {
    q[0][ks] = *(const bf16x8*)(Qp0 + ks * 16 + h * 8);
    q[1][ks] = *(const bf16x8*)(Qp1 + ks * 16 + h * 8);
  }
#pragma unroll
  for (int hq = 0; hq < 2; ++hq)
#pragma unroll
    for (int mv = 0; mv < 2; ++mv)
#pragma unroll
      for (int i = 0; i < 16; ++i) o[hq][mv][i] = 0.f;
  float m_run[2] = {-INFINITY, -INFINITY}, l_run[2] = {0.f, 0.f};
  const int lr = tid >> 3, lc = tid & 7;
  const int wsw = lr * 128 + ((lc ^ ((lr >> 1) & 7)) << 4);
  u32x4 rk, rv;
  auto gload = [&](int ti) {
    const size_t key0 = (size_t)ti * 64;
    rk = *(const u32x4*)(Kb + (key0 + lr) * ldk + lc * 8);
    rv = *(const u32x4*)(Vt + (size_t)lr * S + key0 + lc * 8);
  };
  auto swrite = [&](int st) {
    char* ks_ = lds + st * ATT_STAGE;
    *(u32x4*)(ks_ + wsw) = rk;
    *(u32x4*)(ks_ + 8192 + wsw) = rv;
  };
  const int pr = (r & 0x13) | ((r & 4) << 1) | ((r & 8) >> 1);
  const int ksw = (pr >> 1) & 7;
  const int vsw = (r >> 1) & 7;
  __syncthreads();
  gload(0);
  swrite(0);
  if (ntiles > 1) gload(1);
  __syncthreads();
  for (int ti = 0; ti < ntiles; ++ti) {
    if (ti + 1 < ntiles) {
      swrite((ti + 1) & 1);
      if (ti + 2 < ntiles) gload(ti + 2);
    }
    const char* st = lds + (ti & 1) * ATT_STAGE;
    f32x16 s[2][2];
#pragma unroll
    for (int hq = 0; hq < 2; ++hq)
#pragma unroll
      for (int kb = 0; kb < 2; ++kb)
#pragma unroll
        for (int i = 0; i < 16; ++i) s[hq][kb][i] = 0.f;
    {
      bf16x8 ka[4], kb_[4];
#pragma unroll
      for (int ks = 0; ks < 4; ++ks) {
        const int co = ((2 * ks + h) ^ ksw) << 4;
        ka[ks] = *(const bf16x8*)(st + pr * 128 + co);
        kb_[ks] = *(const bf16x8*)(st + (32 + pr) * 128 + co);
      }
      asm volatile("" ::: "memory");
#pragma unroll
      for (int ks = 0; ks < 4; ++ks) {
        s[0][0] = MFMA(ka[ks], q[0][ks], s[0][0]);
        s[0][1] = MFMA(kb_[ks], q[0][ks], s[0][1]);
        s[1][0] = MFMA(ka[ks], q[1][ks], s[1][0]);
        s[1][1] = MFMA(kb_[ks], q[1][ks], s[1][1]);
      }
    }
    bf16x8 pf[2][2][2];
#pragma unroll
    for (int hq = 0; hq < 2; ++hq) {
      float t[32];
#pragma unroll
      for (int i = 0; i < 16; ++i) { t[i] = s[hq][0][i]; t[16 + i] = s[hq][1][i]; }
      float mx = t[0];
#pragma unroll
      for (int e = 1; e < 32; ++e) mx = fmaxf(mx, t[e]);
      mx = fmaxf(mx, __shfl_xor(mx, 32));
      if (__builtin_amdgcn_ballot_w64(mx > m_run[hq] + 8.f) != 0ull) {
        const float m_new = fmaxf(m_run[hq], mx);
        const float alpha = fexp2(m_run[hq] - m_new);
        l_run[hq] *= alpha;
        m_run[hq] = m_new;
#pragma unroll
        for (int mv = 0; mv < 2; ++mv)
#pragma unroll
          for (int i = 0; i < 16; ++i) o[hq][mv][i] *= alpha;
      }
      float ls = 0.f;
#pragma unroll
      for (int e = 0; e < 32; ++e) { t[e] = fexp2(t[e] - m_run[hq]); ls += t[e]; }
      l_run[hq] += ls;
#pragma unroll
      for (int kb = 0; kb < 2; ++kb)
#pragma unroll
        for (int c2 = 0; c2 < 2; ++c2) {
          const int e0 = kb * 16 + c2 * 8;
          u32x4 pw = {pk_bf16(t[e0], t[e0 + 1]), pk_bf16(t[e0 + 2], t[e0 + 3]), pk_bf16(t[e0 + 4], t[e0 + 5]), pk_bf16(t[e0 + 6], t[e0 + 7])};
          pf[hq][kb][c2] = __builtin_bit_cast(bf16x8, pw);
        }
    }
    bf16x8 vf[2][2][2];
#pragma unroll
    for (int kb = 0; kb < 2; ++kb)
#pragma unroll
      for (int c2 = 0; c2 < 2; ++c2) {
        const int co = ((4 * kb + 2 * c2 + h) ^ vsw) << 4;
#pragma unroll
        for (int mv = 0; mv < 2; ++mv) vf[kb][c2][mv] = *(const bf16x8*)(st + 8192 + (mv * 32 + r) * 128 + co);
      }
    asm volatile("" ::: "memory");
#pragma unroll
    for (int kb = 0; kb < 2; ++kb)
#pragma unroll
      for (int c2 = 0; c2 < 2; ++c2)
#pragma unroll
        for (int mv = 0; mv < 2; ++mv) {
          o[0][mv] = MFMA(vf[kb][c2][mv], pf[0][kb][c2], o[0][mv]);
          o[1][mv] = MFMA(vf[kb][c2][mv], pf[1][kb][c2], o[1][mv]);
        }
    __syncthreads();
  }
#pragma unroll
  for (int hq = 0; hq < 2; ++hq) {
    const float lt = l_run[hq] + __shfl_xor(l_run[hq], 32);
    const float inv = 1.f / lt;
#pragma unroll
    for (int mv = 0; mv < 2; ++mv)
#pragma unroll
      for (int i = 0; i < 16; ++i) o[hq][mv][i] *= inv;
  }
}

DI void flash_pass_na(f32x16 (&o)[2], const u16* __restrict__ Qp, const u16* __restrict__ Kb, int ldk,
                      const u16* __restrict__ Vt, int S, int tile0, int ntiles, char* lds, int wlo, int whi,
                      const float* bias_lds, int qrow, int rs_q, int qcol, int cs0) {
  const int tid = opaque_tid(), lane = tid & 63;
  const int h = lane >> 5, r = lane & 31;
  bf16x8 q[4];
#pragma unroll
  for (int ks = 0; ks < 4; ++ks) q[ks] = *(const bf16x8*)(Qp + ks * 16 + h * 8);
#pragma unroll
  for (int mv = 0; mv < 2; ++mv)
#pragma unroll
    for (int i = 0; i < 16; ++i) o[mv][i] = 0.f;
  float m_run = -1e30f, l_run = 0.f;
  const int lr = tid >> 3, lc = tid & 7;
  const int wsw = lr * 128 + ((lc ^ ((lr >> 1) & 7)) << 4);
  u32x4 rk, rv;
  auto gload = [&](int ti) {
    const size_t key0 = (size_t)(tile0 + ti) * 64;
    rk = *(const u32x4*)(Kb + (key0 + lr) * ldk + lc * 8);
    rv = *(const u32x4*)(Vt + (size_t)lr * S + key0 + lc * 8);
  };
  auto swrite = [&](int st) {
    char* ks_ = lds + st * ATT_STAGE;
    *(u32x4*)(ks_ + wsw) = rk;
    *(u32x4*)(ks_ + 8192 + wsw) = rv;
  };
  const int pr = (r & 0x13) | ((r & 4) << 1) | ((r & 8) >> 1);
  const int krow = cs0 + pr;
  const int ksw = (krow >> 1) & 7;
  const int vsw = (r >> 1) & 7;
  const int vch0 = cs0 >> 3;
  const int csq = min(max(qcol - 8, 0), 48);
  bool navalid[16];
#pragma unroll
  for (int i = 0; i < 16; ++i) {
    const int j = i >> 2;
    const int kc = cs0 + 16 * (j >> 1) + 8 * h + 4 * (j & 1) + (i & 3);
    navalid[i] = (unsigned)(kc - csq) < 16u;
  }
  const int dcb = cs0 + 8 * h - qcol + 15;
  __syncthreads();
  gload(0);
  swrite(0);
  if (ntiles > 1) gload(1);
  __syncthreads();
  for (int ti = 0; ti < ntiles; ++ti) {
    if (ti + 1 < ntiles) {
      swrite((ti + 1) & 1);
      if (ti + 2 < ntiles) gload(ti + 2);
    }
    const char* st = lds + (ti & 1) * ATT_STAGE;
    const int kr = tile0 + ti;
    if (kr >= wlo && kr <= whi) {
      f32x16 s0;
#pragma unroll
      for (int i = 0; i < 16; ++i) s0[i] = 0.f;
      {
        bf16x8 ka[4];
#pragma unroll
        for (int ks = 0; ks < 4; ++ks) ka[ks] = *(const bf16x8*)(st + krow * 128 + (((2 * ks + h) ^ ksw) << 4));
        asm volatile("" ::: "memory");
#pragma unroll
        for (int ks = 0; ks < 4; ++ks) s0 = MFMA(ka[ks], q[ks], s0);
      }
      bf16x8 vf[2][2];
#pragma unroll
      for (int c2 = 0; c2 < 2; ++c2) {
        const int co = ((vch0 + 2 * c2 + h) ^ vsw) << 4;
#pragma unroll
        for (int mv = 0; mv < 2; ++mv) vf[c2][mv] = *(const bf16x8*)(st + 8192 + (mv * 32 + r) * 128 + co);
      }
      asm volatile("" ::: "memory");
      const bool rowok = (kr >= rs_q) && (kr <= rs_q + 7);
      const int bidx = rowok ? ((kr - qrow + 7) * 31 + dcb) : 64;
      float t[16];
#pragma unroll
      for (int i = 0; i < 16; ++i) {
        const int j = i >> 2;
        const int kco = 16 * (j >> 1) + 4 * (j & 1) + (i & 3);
        const bool ok = navalid[i] && rowok;
        const float bv = bias_lds[ok ? (bidx + kco) : 0];
        t[i] = ok ? (s0[i] + bv) : -INFINITY;
      }
      float mx = t[0];
#pragma unroll
      for (int e = 1; e < 16; ++e) mx = fmaxf(mx, t[e]);
      mx = fmaxf(mx, __shfl_xor(mx, 32));
      if (__builtin_amdgcn_ballot_w64(mx > m_run + 8.f) != 0ull) {
        const float m_new = fmaxf(m_run, mx);
        const float alpha = fexp2(m_run - m_new);
        l_run *= alpha;
        m_run = m_new;
#pragma unroll
        for (int mv = 0; mv < 2; ++mv)
#pragma unroll
          for (int i = 0; i < 16; ++i) o[mv][i] *= alpha;
      }
      float ls = 0.f;
#pragma unroll
      for (int e = 0; e < 16; ++e) { t[e] = fexp2(t[e] - m_run); ls += t[e]; }
      l_run += ls;
#pragma unroll
      for (int c2 = 0; c2 < 2; ++c2) {
        const int e0 = c2 * 8;
        u32x4 pw = {pk_bf16(t[e0], t[e0 + 1]), pk_bf16(t[e0 + 2], t[e0 + 3]), pk_bf16(t[e0 + 4], t[e0 + 5]), pk_bf16(t[e0 + 6], t[e0 + 7])};
        const bf16x8 pf = __builtin_bit_cast(bf16x8, pw);
#pragma unroll
        for (int mv = 0; mv < 2; ++mv) o[mv] = MFMA(vf[c2][mv], pf, o[mv]);
      }
    }
    __syncthreads();
  }
  const float lt = l_run + __shfl_xor(l_run, 32);
  const float inv = 1.f / lt;
#pragma unroll
  for (int mv = 0; mv < 2; ++mv)
#pragma unroll
    for (int i = 0; i < 16; ++i) o[mv][i] *= inv;
}

DI void phase_attn0(const Params& p, char* lds) {
  const int tid = opaque_tid(), lane = tid & 63, w = tid >> 6;
  const int h = lane >> 5, r = lane & 31;
  const u16* QK = (const u16*)(p.ws + OFF_BIG);
  const u16* VT = (const u16*)(p.ws + OFF_VT0);
  u16* O = (u16*)(p.ws + OFF_H);
  float* stash = (float*)(p.ws + OFF_STASH) + (((size_t)blockIdx.x * 8 + w) * 64 + lane) * 64;
  float lam;
  {
    const float* lf = p.diff_lambda;
    float a = lf[lane] * lf[64 + lane];
    float b = lf[128 + lane] * lf[192 + lane];
#pragma unroll
    for (int o_ = 1; o_ < 64; o_ <<= 1) { a += __shfl_xor(a, o_); b += __shfl_xor(b, o_); }
    lam = __expf(a) - __expf(b) + 0.2f;
  }
  const int total = 1536;
  const int G = gridDim.x;
  const bool dyn = ((G & 7) == 0);
  unsigned* qhead = (unsigned*)(p.ws + OFF_BAR + 256 * (1 + (blockIdx.x & 7)));
  volatile int* qslot = (volatile int*)(lds + 2 * ATT_STAGE + 4096);
  for (int it0 = 0;; ++it0) {
    int lt;
    if (dyn) {
      __syncthreads();
      if (tid == 0) *qslot = (int)__hip_atomic_fetch_add(qhead, 1u, __ATOMIC_RELAXED, __HIP_MEMORY_SCOPE_AGENT);
      __syncthreads();
      const int k = *qslot;
      const int per = G >> 3;
      const int it = k / per;
      if (it * G >= total) break;
      lt = it * G + (blockIdx.x & 7) * per + (k - it * per);
    } else {
      if (it0 * G >= total) break;
      lt = it0 * G + blockIdx.x;
    }
    if (lt >= total) continue;
    int cls, bb, head, qb, S, tokbase;
    if (lt < 512) { cls = 0; bb = lt >> 8; head = (lt >> 6) & 3; qb = lt & 63; }
    else if (lt < 1024) { int u = lt - 512; cls = 1; bb = u >> 8; head = (u >> 6) & 3; qb = u & 63; }
    else if (lt < 1280) { int u = lt - 1024; cls = 0; bb = 2 + (u >> 5); head = (u >> 3) & 3; qb = u & 7; }
    else { int u = lt - 1280; cls = 1; bb = 2 + (u >> 5); head = (u >> 3) & 3; qb = u & 7; }
    if (bb < 2) { S = SP; tokbase = bb * SP; } else { S = SS; tokbase = NTOK_P + (bb - 2) * SS; }
    const int tq = tokbase + qb * 256 + w * 32 + r;
    const u16* Kseq = QK + (size_t)tokbase * QK0_LD;
    const u16* Vseq = VT + (size_t)640 * tokbase;
    if (cls == 0) {
      f32x16 o[4];
#pragma unroll 1
      for (int comp = 0; comp < 2; ++comp) {
        const int hc = head * 2 + comp;
        flash_pass<128, false>(o, QK + (size_t)tq * QK0_LD + hc * 64, Kseq + 512 + hc * 64, QK0_LD,
                               Vseq + (size_t)(head * 128) * S, S, 0, S >> 6, lds, QK_SCALE_LOG2, 0, 0, nullptr, 0, 0);
        if (comp == 0) {
#pragma unroll
          for (int mv = 0; mv < 4; ++mv) {
#pragma unroll
            for (int i = 0; i < 4; ++i) {
              float4 v4 = {o[mv][4 * i], o[mv][4 * i + 1], o[mv][4 * i + 2], o[mv][4 * i + 3]};
              *(float4*)(stash + mv * 16 + i * 4) = v4;
            }
            asm volatile("" ::: "memory");
          }
        }
      }
      float ss = 0.f;
#pragma unroll
      for (int mv = 0; mv < 4; ++mv) {
#pragma unroll
        for (int i = 0; i < 4; ++i) {
          const float4 s4 = *(const float4*)(stash + mv * 16 + i * 4);
          float v;
          v = s4.x - lam * o[mv][4 * i]; o[mv][4 * i] = v; ss += v * v;
          v = s4.y - lam * o[mv][4 * i + 1]; o[mv][4 * i + 1] = v; ss += v * v;
          v = s4.z - lam * o[mv][4 * i + 2]; o[mv][4 * i + 2] = v; ss += v * v;
          v = s4.w - lam * o[mv][4 * i + 3]; o[mv][4 * i + 3] = v; ss += v * v;
        }
        asm volatile("" ::: "memory");
      }
      ss += __shfl_xor(ss, 32);
      const float rs = rsqrtf(ss * (1.f / 128.f) + 1e-5f) * 0.8f;
      u16* orow = O + (size_t)tq * DM + head * 128;
#pragma unroll
      for (int mv = 0; mv < 4; ++mv) {
#pragma unroll
        for (int jp = 0; jp < 2; ++jp) {
          u32x2 XY[2];
#pragma unroll
          for (int jj = 0; jj < 2; ++jj) {
            const int j = 2 * jp + jj;
            const float4 g = *(const float4*)(p.diff_subln_g + mv * 32 + 8 * j + 4 * h);
            XY[jj] = (u32x2){pk_bf16(o[mv][4 * j] * rs * g.x, o[mv][4 * j + 1] * rs * g.y),
                             pk_bf16(o[mv][4 * j + 2] * rs * g.z, o[mv][4 * j + 3] * rs * g.w)};
          }
          half_swap(XY[0], XY[1]);
          u32x4 v = {XY[0].x, XY[0].y, XY[1].x, XY[1].y};
          *(u32x4*)(orow + mv * 32 + 16 * jp + 8 * h) = v;
        }
        asm volatile("" ::: "memory");
      }
    } else {
      f32x16 o[2][2];
      const int kvh = head >> 1;
      const u16* qrow = QK + (size_t)tq * QK0_LD + 1024 + (2 * head) * 64;
      flash_pass_q2(o, qrow, qrow + 64, Kseq + 1536 + kvh * 64, QK0_LD, Vseq + (size_t)(512 + kvh * 64) * S, S, S >> 6, lds);
#pragma unroll
      for (int hq = 0; hq < 2; ++hq) {
        u16* orow = O + (size_t)tq * DM + 512 + (2 * head + hq) * 64;
#pragma unroll
        for (int mv = 0; mv < 2; ++mv)
#pragma unroll
          for (int jp = 0; jp < 2; ++jp) {
            u32x2 X = {pk_bf16(o[hq][mv][8 * jp], o[hq][mv][8 * jp + 1]), pk_bf16(o[hq][mv][8 * jp + 2], o[hq][mv][8 * jp + 3])};
            u32x2 Y = {pk_bf16(o[hq][mv][8 * jp + 4], o[hq][mv][8 * jp + 5]), pk_bf16(o[hq][mv][8 * jp + 6], o[hq][mv][8 * jp + 7])};
            half_swap(X, Y);
            u32x4 v = {X.x, X.y, Y.x, Y.y};
            *(u32x4*)(orow + mv * 32 + 16 * jp + 8 * h) = v;
          }
      }
    }
  }
}

DI void phase_na(const Params& p, char* lds) {
  const int tid = opaque_tid(), lane = tid & 63, w = tid >> 6;
  const int h = lane >> 5, r = lane & 31;
  const u16* QK = (const u16*)(p.ws + OFF_BIG);
  const u16* VT = (const u16*)(p.ws + OFF_VT1);
  u16* O = (u16*)(p.ws + OFF_H);
  float* bias = (float*)(lds + 2 * ATT_STAGE);
  const int total = 3072;
  for (int it = 0; it * (int)gridDim.x < total; ++it) {
    const int lt = logical_index(it);
    if (lt >= total) continue;
    int bb, head, r4, S, tokbase, rows;
    if (lt < 2048) { bb = lt >> 10; head = (lt >> 6) & 15; r4 = lt & 63; S = SP; tokbase = bb * SP; rows = 256; }
    else { int u = lt - 2048; bb = 2 + (u >> 7); head = (u >> 3) & 15; r4 = u & 7; S = SS; tokbase = NTOK_P + (bb - 2) * SS; rows = 32; }
    __syncthreads();
    for (int e = tid; e < 465; e += NTHR) bias[e] = p.odd_rpb[head * 465 + e] * 1.4426950408889634f;
    const int rfirst = r4 * 4, rlast = r4 * 4 + 3;
    const int rs_first = min(max(rfirst - 4, 0), rows - 8);
    const int rs_last = min(max(rlast - 4, 0), rows - 8);
    const int ntiles = rs_last + 8 - rs_first;
    const int rp0 = rfirst + 2 * (w >> 2);
    const int cq = w & 3;
    const int qrow = rp0 + (r >> 4);
    const int qcol = 16 * cq + (r & 15);
    const int rs_q = min(max(qrow - 4, 0), rows - 8);
    const int wlo = min(max(rp0 - 4, 0), rows - 8);
    const int whi = min(max(rp0 + 1 - 4, 0), rows - 8) + 7;
    const int cs0 = min(max(16 * cq - 8, 0), 32);
    const int tq = tokbase + qrow * 64 + qcol;
    f32x16 o[2];
    flash_pass_na(o, QK + (size_t)tq * QK1_LD + head * 64, QK + (size_t)tokbase * QK1_LD + 1024 + head * 64, QK1_LD,
                  VT + (size_t)1024 * tokbase + (size_t)(head * 64) * S, S, rs_first, ntiles, lds,
                  wlo, whi, bias, qrow, rs_q, qcol, cs0);
    u16* orow = O + (size_t)tq * DM + head * 64;
#pragma unroll
    for (int mv = 0; mv < 2; ++mv)
#pragma unroll
      for (int jp = 0; jp < 2; ++jp) {
        u32x2 X = {pk_bf16(o[mv][8 * jp], o[mv][8 * jp + 1]), pk_bf16(o[mv][8 * jp + 2], o[mv][8 * jp + 3])};
        u32x2 Y = {pk_bf16(o[mv][8 * jp + 4], o[mv][8 * jp + 5]), pk_bf16(o[mv][8 * jp + 6], o[mv][8 * jp + 7])};
        half_swap(X, Y);
        u32x4 v = {X.x, X.y, Y.x, Y.y};
        *(u32x4*)(orow + mv * 32 + 16 * jp + 8 * h) = v;
      }
  }
}

DI void grid_barrier(unsigned* ctr, unsigned target) {
  asm volatile("s_waitcnt vmcnt(0)" ::: "memory");
  __syncthreads();
  if (threadIdx.x == 0) {
    __builtin_amdgcn_fence(__ATOMIC_RELEASE, "agent");
    asm volatile("s_waitcnt vmcnt(0)" ::: "memory");
    __hip_atomic_fetch_add(ctr, 1u, __ATOMIC_RELAXED, __HIP_MEMORY_SCOPE_AGENT);
    while (__hip_atomic_load(ctr, __ATOMIC_RELAXED, __HIP_MEMORY_SCOPE_AGENT) < target) __builtin_amdgcn_s_sleep(1);
    __builtin_amdgcn_fence(__ATOMIC_ACQUIRE, "agent");
    asm volatile("s_waitcnt vmcnt(0)" ::: "memory");
  }
  __syncthreads();
}

__global__ void __launch_bounds__(NTHR) mega(Params p, int ph0, int ph1) {
  __shared__ __attribute__((aligned(16))) char lds[LDS_BYTES];
  unsigned* bar = (unsigned*)(p.ws + OFF_BAR);
  if (ph0 == 0 && blockIdx.x == 0 && threadIdx.x < 9)
    __hip_atomic_store((unsigned*)(p.ws + OFF_BAR + 256 * threadIdx.x), 0u, __ATOMIC_RELAXED, __HIP_MEMORY_SCOPE_AGENT);
  if (ph0 == 0 && blockIdx.x == 0 && threadIdx.x >= 64 && threadIdx.x < 128) ((unsigned*)(p.ws + OFF_ZERO))[threadIdx.x - 64] = 0u;
  unsigned nbar = 0;
  for (int ph = ph0; ph < ph1; ++ph) {
    if (ph > ph0) {
      if (ph == ph0 + 1) cg::this_grid().sync();
      else { ++nbar; grid_barrier(bar, nbar * gridDim.x); }
    }
    const u16* H = (const u16*)(p.ws + OFF_H);
    u16* Hm = (u16*)(p.ws + OFF_H);
    const u16* Abuf = (const u16*)(p.ws + OFF_BIG);
    u16* Bm = (u16*)(p.ws + OFF_BIG);
    switch (ph) {
      case 0:
        for (int item = blockIdx.x; item < 6528; item += gridDim.x) phase0_item(p, item, lds);
        break;
      case 1: phase_ln(p, 0, 0, true, false, nullptr, 0, 0); break;
      case 2: { GemmArgs ga{H, DM, (const u16*)(p.ws + OFF_WT_IN), 1024, 9, 0, nullptr}; phase_gemm<EPI_INPROJ>(p, ga, lds); } break;
      case 3: phase_attn0(p, lds); break;
      case 5: phase_ln(p, 0, 1, true, false, Abuf, 0, 2048); break;
      case 6: { GemmArgs ga{H, DM, (const u16*)(p.ws + OFF_WT_UP0), 1024, 22, 0, nullptr}; phase_gemm<EPI_UP>(p, ga, lds); } break;
      case 8: phase_ln(p, 1, 0, false, false, H, 0, 5120); break;
      case 9: { GemmArgs ga{H, DM, (const u16*)(p.ws + OFF_WT_QKV), 1024, 12, 1, nullptr}; phase_gemm<EPI_QKV1>(p, ga, lds); } break;
      case 10: phase_na(p, lds); break;
      case 12: phase_ln(p, 1, 1, false, false, Abuf, 1, 2048); break;
      case 13: { GemmArgs ga{H, DM, (const u16*)(p.ws + OFF_WT_UP1), 1024, 22, 1, nullptr}; phase_gemm<EPI_UP>(p, ga, lds); } break;
      case 15: phase_ln(p, 0, 0, false, true, H, 1, 5120); break;
      case 4: case 7: case 11: case 14: {
        GemmArgs ga;
        if (ph == 4) ga = GemmArgs{H, DM, (const u16*)(p.ws + OFF_WT_OUT0), 1024, 4, 0, Bm};
        else if (ph == 7) ga = GemmArgs{Abuf, DFF, (const u16*)(p.ws + OFF_WT_DN0), 2816, 4, 0, Hm};
        else if (ph == 11) ga = GemmArgs{H, DM, (const u16*)(p.ws + OFF_WT_OUT1), 1024, 4, 1, Bm};
        else ga = GemmArgs{Abuf, DFF, (const u16*)(p.ws + OFF_WT_DN1), 2816, 4, 1, Hm};
        phase_gemm<EPI_M>(p, ga, lds);
      } break;
      default: break;
    }
  }
}

extern "C" void kernel_launch(void* const* d_in, const int* in_sizes, int n_in, void* d_out, int out_size,
                              void* d_ws, size_t ws_size, hipStream_t stream) {
  static int grid_blocks = 0;
  if (!grid_blocks) {
    int dev = 0, cus = 0, per_cu = 0;
    hipGetDevice(&dev);
    hipDeviceGetAttribute(&cus, hipDeviceAttributeMultiprocessorCount, dev);
    hipOccupancyMaxActiveBlocksPerMultiprocessor(&per_cu, mega, NTHR, 0);
    if (per_cu < 1) per_cu = 1;
    if (per_cu > 1) per_cu = 1;
    grid_blocks = cus * per_cu;
    if (grid_blocks > 256) grid_blocks = 256;
    if (grid_blocks < 1) grid_blocks = 1;
  }
  if (ws_size < WS_NEEDED) fprintf(stderr, "workspace too small: %zu < %zu\n", ws_size, (size_t)WS_NEEDED);
  Params p{};
  p.x_prompt = (const float*)d_in[0]; p.x_sample = (const float*)d_in[1];
  p.c_prompt = (const float*)d_in[2]; p.c_sample = (const float*)d_in[3];
  p.ada_w = (const float*)d_in[4]; p.ada_b = (const float*)d_in[5]; p.norm_g = (const float*)d_in[6];
  p.even_w_in = (const float*)d_in[7]; p.even_w_out = (const float*)d_in[8];
  p.diff_lambda = (const float*)d_in[9]; p.diff_subln_g = (const float*)d_in[10]; p.gqa_qk_g = (const float*)d_in[11];
  p.odd_w_qkv = (const float*)d_in[12]; p.odd_rpb = (const float*)d_in[13]; p.odd_w_out = (const float*)d_in[14];
  p.ffn_w_up = (const float*)d_in[15]; p.ffn_conv_w = (const float*)d_in[16]; p.ffn_conv_b = (const float*)d_in[17];
  p.ffn_w_down = (const float*)d_in[18]; p.final_g = (const float*)d_in[19];
  p.out = (float*)d_out;
  p.ws = (char*)d_ws;
#if ONE_LAUNCH
  int ph0 = 0, ph1 = NPHASE;
  void* args[] = {&p, &ph0, &ph1};
  hipError_t e = hipLaunchCooperativeKernel((void*)mega, dim3(grid_blocks), dim3(NTHR), args, 0, stream);
  if (e != hipSuccess) fprintf(stderr, "cooperative launch failed: %s (grid %d)\n", hipGetErrorString(e), grid_blocks);
#else
  for (int ph = 0; ph < NPHASE; ++ph) mega<<<dim3(grid_blocks), dim3(NTHR), 0, stream>>>(p, ph, ph + 1);
#endif
}
```

```cpp
#include <hip/hip_runtime.h>
#include <hip/hip_cooperative_groups.h>
#include <cstdio>
namespace cg = cooperative_groups;

typedef unsigned short u16;
typedef __attribute__((ext_vector_type(8))) short bf16x8;
typedef __attribute__((ext_vector_type(16))) float f32x16;
typedef __attribute__((ext_vector_type(4))) unsigned u32x4;
typedef __attribute__((ext_vector_type(2))) unsigned u32x2;
typedef __attribute__((ext_vector_type(2))) float f32x2;
typedef __attribute__((ext_vector_type(2))) __bf16 bf16v2;
typedef __attribute__((ext_vector_type(4))) float f32x4v;

#define DI __device__ __forceinline__
#define MFMA(a, b, c) __builtin_amdgcn_mfma_f32_32x32x16_bf16((a), (b), (c), 0, 0, 0)

#ifndef ONE_LAUNCH
#define ONE_LAUNCH 1
#endif

constexpr int NTHR = 512;
constexpr int DM = 1024;
constexpr int NTOK = 49152;
constexpr int NTOK_P = 32768;
constexpr int SP = 16384, SS = 2048;
constexpr int DFF = 2816;
constexpr int QK0_LD = 1664;
constexpr int QK1_LD = 2048;
constexpr int NPHASE = 16;

constexpr size_t OFF_WT_IN = 0;
constexpr size_t OFF_WT_OUT0 = OFF_WT_IN + (size_t)2304 * 1024 * 2;
constexpr size_t OFF_WT_UP0 = OFF_WT_OUT0 + (size_t)1024 * 1024 * 2;
constexpr size_t OFF_WT_UP1 = OFF_WT_UP0 + (size_t)5632 * 1024 * 2;
constexpr size_t OFF_WT_DN0 = OFF_WT_UP1 + (size_t)5632 * 1024 * 2;
constexpr size_t OFF_WT_DN1 = OFF_WT_DN0 + (size_t)1024 * 2816 * 2;
constexpr size_t OFF_WT_QKV = OFF_WT_DN1 + (size_t)1024 * 2816 * 2;
constexpr size_t OFF_WT_OUT1 = OFF_WT_QKV + (size_t)3072 * 1024 * 2;
constexpr size_t OFF_MOD = OFF_WT_OUT1 + (size_t)1024 * 1024 * 2;
constexpr size_t OFF_CS1 = OFF_MOD + (size_t)2 * 10 * 6144 * 4;
constexpr size_t OFF_CS2 = OFF_CS1 + (size_t)16384 * 32 * 8;
constexpr size_t OFF_H = OFF_CS2 + (size_t)16384 * 32 * 8;
constexpr size_t OFF_BIG = OFF_H + (size_t)NTOK * 1024 * 2;
constexpr size_t BIG_BYTES = (size_t)NTOK * 3072 * 2;
constexpr size_t OFF_VT0 = OFF_BIG + (size_t)NTOK * QK0_LD * 2;
constexpr size_t OFF_VT1 = OFF_BIG + (size_t)NTOK * QK1_LD * 2;
constexpr size_t OFF_STASH = OFF_BIG + BIG_BYTES;
constexpr size_t STASH_PER_BLOCK = (size_t)8 * 64 * 64 * 4;
constexpr size_t OFF_BAR = OFF_STASH + 256 * STASH_PER_BLOCK;
constexpr size_t OFF_ZERO = OFF_BAR + 4096;
constexpr size_t WS_NEEDED = OFF_ZERO + 256;

constexpr int LDS_BYTES = 133120;
constexpr float QK_SCALE_LOG2 = 0.125f * 1.4426950408889634f;

__device__ const float INV1[32] = {1.000000000e+00f, 7.498942614e-01f, 5.623413324e-01f, 4.216965139e-01f, 3.162277639e-01f, 2.371373773e-01f, 1.778279394e-01f, 1.333521307e-01f, 1.000000015e-01f, 7.498941571e-02f, 5.623413250e-02f, 4.216965288e-02f, 3.162277490e-02f, 2.371373773e-02f, 1.778279431e-02f, 1.333521493e-02f, 9.999999776e-03f, 7.498941850e-03f, 5.623413250e-03f, 4.216964822e-03f, 3.162277630e-03f, 2.371373586e-03f, 1.778279431e-03f, 1.333521446e-03f, 1.000000047e-03f, 7.498942432e-04f, 5.623413017e-04f, 4.216965172e-04f, 3.162277571e-04f, 2.371373703e-04f, 1.778279402e-04f, 1.333521504e-04f};
__device__ const float INV2[16] = {1.000000000e+00f, 5.623413324e-01f, 3.162277639e-01f, 1.778279394e-01f, 1.000000015e-01f, 5.623413250e-02f, 3.162277490e-02f, 1.778279431e-02f, 9.999999776e-03f, 5.623413250e-03f, 3.162277630e-03f, 1.778279431e-03f, 1.000000047e-03f, 5.623413017e-04f, 3.162277571e-04f, 1.778279402e-04f};

struct Params {
  const float *x_prompt, *x_sample, *c_prompt, *c_sample, *ada_w, *ada_b, *norm_g, *even_w_in, *even_w_out,
      *diff_lambda, *diff_subln_g, *gqa_qk_g, *odd_w_qkv, *odd_rpb, *odd_w_out, *ffn_w_up, *ffn_conv_w,
      *ffn_conv_b, *ffn_w_down, *final_g;
  float* out;
  char* ws;
};

DI unsigned pk_bf16(float a, float b) {
  f32x2 v = {a, b};
  bf16v2 r = __builtin_convertvector(v, bf16v2);
  return __builtin_bit_cast(unsigned, r);
}
DI u16 to_bf16(float a) { return (u16)(pk_bf16(a, 0.f) & 0xffffu); }
DI float bf16_to_f(u16 v) { return __uint_as_float(((unsigned)v) << 16); }
DI void half_swap(u32x2& X, u32x2& Y) {
  typedef __attribute__((ext_vector_type(2))) unsigned u2_;
  const u2_ a = __builtin_amdgcn_permlane32_swap(X.x, Y.x, false, false);
  const u2_ b = __builtin_amdgcn_permlane32_swap(X.y, Y.y, false, false);
  X.x = a.x; Y.x = a.y; X.y = b.x; Y.y = b.y;
}
DI int opaque_tid() { int t = threadIdx.x; asm volatile("" : "+v"(t)); return t; }
DI float fexp2(float x) { return __builtin_amdgcn_exp2f(x); }
DI int swz(int row, int chunk) { return row * 128 + ((chunk ^ ((row >> 1) & 7)) << 4); }
DI int crow(int i, int h) { return (i & 3) + 8 * (i >> 2) + 4 * h; }
DI void seq_of_token(int t, int& bb, int& tokbase, int& S) {
  if (t < NTOK_P) { bb = t >> 14; tokbase = bb << 14; S = SP; }
  else { int u = (t - NTOK_P) >> 11; bb = 2 + u; tokbase = NTOK_P + (u << 11); S = SS; }
}
DI const float* xin_row(const Params& p, int t) {
  return (t < NTOK_P) ? (p.x_prompt + (size_t)t * DM) : (p.x_sample + (size_t)(t - NTOK_P) * DM);
}
DI int logical_index(int it) {
  const int G = gridDim.x, b = blockIdx.x;
  if ((G & 7) == 0) return it * G + (b & 7) * (G >> 3) + (b >> 3);
  return it * G + b;
}

DI void phase0_item(const Params& p, int item, char* lds) {
  const int tid = opaque_tid();
  if (item < 192) {
    const int l = item / 96, jc = item % 96;
    float* cact = (float*)lds;
    float* red = (float*)(lds + 40960);
    for (int e = tid; e < 10240; e += NTHR) {
      int bb = e >> 10, k = e & 1023;
      float c = (bb < 2) ? p.c_prompt[bb * 1024 + k] : p.c_sample[(bb - 2) * 1024 + k];
      cact[e] = c / (1.f + __expf(-c));
    }
    __syncthreads();
    const int c4 = tid & 15, kg = tid >> 4;
    float4 acc[10];
#pragma unroll
    for (int b = 0; b < 10; ++b) acc[b] = (float4){0.f, 0.f, 0.f, 0.f};
    const float* w = p.ada_w + (size_t)l * 1024 * 6144 + (size_t)(kg * 32) * 6144 + jc * 64 + c4 * 4;
#pragma unroll 8
    for (int k = 0; k < 32; ++k) {
      const float4 wv = *(const float4*)(w + (size_t)k * 6144);
#pragma unroll
      for (int b = 0; b < 10; ++b) {
        const float cv = cact[b * 1024 + kg * 32 + k];
        acc[b].x += cv * wv.x; acc[b].y += cv * wv.y; acc[b].z += cv * wv.z; acc[b].w += cv * wv.w;
      }
    }
#pragma unroll
    for (int b = 0; b < 10; ++b) *(float4*)(red + (kg * 10 + b) * 64 + c4 * 4) = acc[b];
    __syncthreads();
    for (int e = tid; e < 640; e += NTHR) {
      int b = e >> 6, c = e & 63;
      float s_ = p.ada_b[l * 6144 + jc * 64 + c];
#pragma unroll 8
      for (int g = 0; g < 32; ++g) s_ += red[(g * 10 + b) * 64 + c];
      ((float*)(p.ws + OFF_MOD))[(l * 10 + b) * 6144 + jc * 64 + c] = s_;
    }
    __syncthreads();
    return;
  }
  item -= 192;
  if (item < 6080) {
    const float* src; u16* dst; int K, N, perm = 0, tl;
    if (item < 576) { src = p.even_w_in; dst = (u16*)(p.ws + OFF_WT_IN); K = 1024; N = 2304; tl = item; }
    else if (item < 832) { src = p.even_w_out; dst = (u16*)(p.ws + OFF_WT_OUT0); K = 1024; N = 1024; tl = item - 576; }
    else if (item < 2240) { src = p.ffn_w_up; dst = (u16*)(p.ws + OFF_WT_UP0); K = 1024; N = 5632; perm = 1; tl = item - 832; }
    else if (item < 3648) { src = p.ffn_w_up + (size_t)1024 * 5632; dst = (u16*)(p.ws + OFF_WT_UP1); K = 1024; N = 5632; perm = 1; tl = item - 2240; }
    else if (item < 4352) { src = p.ffn_w_down; dst = (u16*)(p.ws + OFF_WT_DN0); K = 2816; N = 1024; tl = item - 3648; }
    else if (item < 5056) { src = p.ffn_w_down + (size_t)2816 * 1024; dst = (u16*)(p.ws + OFF_WT_DN1); K = 2816; N = 1024; tl = item - 4352; }
    else if (item < 5824) { src = p.odd_w_qkv; dst = (u16*)(p.ws + OFF_WT_QKV); K = 1024; N = 3072; tl = item - 5056; }
    else { src = p.odd_w_out; dst = (u16*)(p.ws + OFF_WT_OUT1); K = 1024; N = 1024; tl = item - 5824; }
    const int ntn = N >> 6;
    const int k0 = (tl / ntn) << 6, n0 = (tl % ntn) << 6;
    float* T = (float*)lds;
    {
      const int kk = tid >> 4, n4 = tid & 15;
#pragma unroll
      for (int i = 0; i < 2; ++i) {
        const float4 v = *(const float4*)(src + (size_t)(k0 + kk + 32 * i) * N + n0 + 4 * n4);
        float* tr = T + (kk + 32 * i) * 65 + 4 * n4;
        tr[0] = v.x; tr[1] = v.y; tr[2] = v.z; tr[3] = v.w;
      }
    }
    __syncthreads();
    {
      const int nn = tid >> 3, k8 = tid & 7;
      const int n = n0 + nn;
      int row = n;
      if (perm) {
        if (n < DFF) row = ((n >> 7) << 8) + (n & 127);
        else { int n2 = n - DFF; row = ((n2 >> 7) << 8) + 128 + (n2 & 127); }
      }
      const float* tc = T + (8 * k8) * 65 + nn;
      u32x4 o4 = {pk_bf16(tc[0], tc[65]), pk_bf16(tc[130], tc[195]), pk_bf16(tc[260], tc[325]), pk_bf16(tc[390], tc[455])};
      *(u32x4*)(dst + (size_t)row * K + k0 + 8 * k8) = o4;
    }
    __syncthreads();
    return;
  }
  item -= 6080;
  {
#pragma unroll
    for (int i = 0; i < 8; ++i) {
      int e = item * 4096 + i * 512 + tid;
      int tab = e >> 19;
      int ee = e & 524287;
      int t = ee >> 5, j = ee & 31;
      float ang;
      if (tab == 0) ang = (float)t * INV1[j];
      else ang = (j < 16) ? (float)(t >> 6) * INV2[j] : (float)(t & 63) * INV2[j - 16];
      double rev = (double)ang * 0.15915494309189533577;
      double fr = rev - rint(rev);
      float f = (float)fr;
      f32x2 cs = {__builtin_amdgcn_cosf(f), __builtin_amdgcn_sinf(f)};
      ((f32x2*)(p.ws + (tab ? OFF_CS2 : OFF_CS1)))[ee] = cs;
    }
  }
}

DI void phase_ln(const Params& p, int layer, int sub, bool first, bool final_, const u16* M, int glayer, int goff) {
  const int tid = opaque_tid(), lane = tid & 63, w = tid >> 6;
  const float* gn = final_ ? p.final_g : (p.norm_g + (layer * 2 + sub) * 1024);
  const float* mod = (const float*)(p.ws + OFF_MOD);
  u16* H = (u16*)(p.ws + OFF_H);
  const int nw = gridDim.x * 8, gw = blockIdx.x * 8 + w;
  const int rows_per = (NTOK + nw - 1) / nw;
  const int r0 = gw * rows_per;
  const int r1 = (r0 + rows_per < NTOK) ? (r0 + rows_per) : NTOK;
  if (r0 >= r1) return;
  auto load_row = [&](int row, float4 (&v)[4], u32x2 (&mm)[4]) {
    const float* xr = first ? xin_row(p, row) : (p.out + (size_t)row * DM);
#pragma unroll
    for (int j = 0; j < 4; ++j) {
      const f32x4v t_ = __builtin_nontemporal_load((const f32x4v*)(xr + j * 256 + lane * 4));
      v[j] = (float4){t_.x, t_.y, t_.z, t_.w};
    }
    if (M) {
#pragma unroll
      for (int j = 0; j < 4; ++j) mm[j] = *(const u32x2*)(M + (size_t)row * DM + j * 256 + lane * 4);
    }
  };
  float4 pg[4], psh[4], pgm[4];
  int cur_bb = -1;
  float4 v[4], vn[4], vn2[4];
  u32x2 mm[4], mmn[4], mmn2[4];
#pragma unroll
  for (int j = 0; j < 4; ++j) {
    mm[j] = (u32x2){0u, 0u}; mmn[j] = (u32x2){0u, 0u}; mmn2[j] = (u32x2){0u, 0u};
    vn[j] = (float4){0.f, 0.f, 0.f, 0.f}; vn2[j] = (float4){0.f, 0.f, 0.f, 0.f};
  }
  load_row(r0, v, mm);
  if (r0 + 1 < r1) load_row(r0 + 1, vn, mmn);
  for (int row = r0; row < r1; ++row) {
    if (row + 2 < r1) load_row(row + 2, vn2, mmn2);
    int bb, tokbase, S;
    seq_of_token(row, bb, tokbase, S);
    if (bb != cur_bb) {
      cur_bb = bb;
      const float* mrow = mod + (layer * 10 + bb) * 6144 + sub * 3072;
      const float* grow = mod + (glayer * 10 + bb) * 6144 + goff;
#pragma unroll
      for (int j = 0; j < 4; ++j) {
        const int c = j * 256 + lane * 4;
        const float4 g = *(const float4*)(gn + c);
        if (final_) { pg[j] = g; psh[j] = (float4){0.f, 0.f, 0.f, 0.f}; }
        else {
          const float4 sh = *(const float4*)(mrow + c);
          const float4 sc = *(const float4*)(mrow + 1024 + c);
          pg[j] = (float4){g.x * (1.f + sc.x), g.y * (1.f + sc.y), g.z * (1.f + sc.z), g.w * (1.f + sc.w)};
          psh[j] = sh;
        }
        if (M) pgm[j] = *(const float4*)(grow + c);
      }
    }
    if (M) {
#pragma unroll
      for (int j = 0; j < 4; ++j) {
        const int c = j * 256 + lane * 4;
        v[j].x += pgm[j].x * __uint_as_float(mm[j].x << 16);
        v[j].y += pgm[j].y * __uint_as_float(mm[j].x & 0xffff0000u);
        v[j].z += pgm[j].z * __uint_as_float(mm[j].y << 16);
        v[j].w += pgm[j].w * __uint_as_float(mm[j].y & 0xffff0000u);
        if (!final_) {
          const f32x4v t_ = {v[j].x, v[j].y, v[j].z, v[j].w};
          __builtin_nontemporal_store(t_, (f32x4v*)(p.out + (size_t)row * DM + c));
        }
      }
    }
    float ss = 0.f;
#pragma unroll
    for (int j = 0; j < 4; ++j) ss += v[j].x * v[j].x + v[j].y * v[j].y + v[j].z * v[j].z + v[j].w * v[j].w;
#pragma unroll
    for (int o = 1; o < 64; o <<= 1) ss += __shfl_xor(ss, o);
    const float rstd = rsqrtf(ss * (1.f / 1024.f) + 1e-6f);
    if (final_) {
#pragma unroll
      for (int j = 0; j < 4; ++j) {
        float4 o4 = {v[j].x * rstd * pg[j].x, v[j].y * rstd * pg[j].y, v[j].z * rstd * pg[j].z, v[j].w * rstd * pg[j].w};
        const f32x4v t_ = {o4.x, o4.y, o4.z, o4.w};
        __builtin_nontemporal_store(t_, (f32x4v*)(p.out + (size_t)row * DM + j * 256 + lane * 4));
      }
    } else {
#pragma unroll
      for (int j = 0; j < 4; ++j) {
        const int c = j * 256 + lane * 4;
        const float a0 = v[j].x * rstd * pg[j].x + psh[j].x;
        const float a1 = v[j].y * rstd * pg[j].y + psh[j].y;
        const float a2 = v[j].z * rstd * pg[j].z + psh[j].z;
        const float a3 = v[j].w * rstd * pg[j].w + psh[j].w;
        u32x2 o2 = {pk_bf16(a0, a1), pk_bf16(a2, a3)};
        *(u32x2*)(H + (size_t)row * DM + c) = o2;
      }
    }
#pragma unroll
    for (int j = 0; j < 4; ++j) { v[j] = vn[j]; mm[j] = mmn[j]; vn[j] = vn2[j]; mmn[j] = mmn2[j]; }
  }
}

template <bool SWAP>
DI void gemm_mainloop(f32x16 (&acc)[4][2], const u16* __restrict__ A, int lda, int rlo, int rhi,
                      const u16* __restrict__ B, int ldb, int K, char* lds, const u16* zero_line) {
  const int tid = opaque_tid(), lane = tid & 63, w = tid >> 6;
  const int wm = w >> 2, wn = w & 3;
  const int h = lane >> 5, r = lane & 31;
  const int lr = tid >> 3, lc = tid & 7;
#pragma unroll
  for (int mi = 0; mi < 4; ++mi)
#pragma unroll
    for (int ni = 0; ni < 2; ++ni)
#pragma unroll
      for (int i = 0; i < 16; ++i) acc[mi][ni][i] = 0.f;
  const int gch = (lc ^ ((lr >> 1) & 7)) * 8;
  const u16* ap = A + (ptrdiff_t)lr * lda + gch;
  const u16* bp = B + (ptrdiff_t)lr * ldb + gch;
  const int nk = K >> 6;
  typedef __attribute__((address_space(3))) unsigned lds_u32;
  auto glds = [&](int kt, int st) {
    char* as_ = lds + st * 65536 + tid * 16;
#pragma unroll
    for (int i = 0; i < 4; ++i) {
      const int rr = lr + 64 * i;
      const u16* srca = (rr >= rlo && rr < rhi) ? (ap + (ptrdiff_t)(64 * i) * lda + kt * 64) : (zero_line + lc * 8);
      __builtin_amdgcn_global_load_lds((const unsigned*)srca, (lds_u32*)(as_ + i * 8192), 16, 0, 0);
      __builtin_amdgcn_global_load_lds((const unsigned*)(bp + (ptrdiff_t)(64 * i) * ldb + kt * 64), (lds_u32*)(as_ + 32768 + i * 8192), 16, 0, 0);
    }
  };
  const int sw = (r >> 1) & 7;
  const int arow_off = (wm * 128 + r) * 128;
  const int brow_off = 32768 + (wn * 64 + r) * 128;
  __syncthreads();
  glds(0, 0);
  asm volatile("s_waitcnt vmcnt(0)" ::: "memory");
  __syncthreads();
  bf16x8 fa[2][4], fb[2][2];
#pragma unroll
  for (int mi = 0; mi < 4; ++mi)
#pragma unroll
    for (int e = 0; e < 8; ++e) fa[1][mi][e] = 0;
#pragma unroll
  for (int ni = 0; ni < 2; ++ni)
#pragma unroll
    for (int e = 0; e < 8; ++e) fb[1][ni][e] = 0;
  auto ldfrag = [&](const char* st, int ks, int buf) {
    const int co = ((2 * ks + h) ^ sw) << 4;
#pragma unroll
    for (int mi = 0; mi < 4; ++mi) fa[buf][mi] = *(const bf16x8*)(st + arow_off + mi * 4096 + co);
#pragma unroll
    for (int ni = 0; ni < 2; ++ni) fb[buf][ni] = *(const bf16x8*)(st + brow_off + ni * 4096 + co);
  };
  auto mma = [&](int buf) {
#pragma unroll
    for (int mi = 0; mi < 4; ++mi)
#pragma unroll
      for (int ni = 0; ni < 2; ++ni)
        acc[mi][ni] = SWAP ? MFMA(fb[buf][ni], fa[buf][mi], acc[mi][ni]) : MFMA(fa[buf][mi], fb[buf][ni], acc[mi][ni]);
  };
  auto pat_rd = [&]() {
#pragma unroll
    for (int g = 0; g < 6; ++g) {
      __builtin_amdgcn_sched_group_barrier(0x100, 1, 0);
      __builtin_amdgcn_sched_group_barrier(0x008, 1, 0);
    }
    __builtin_amdgcn_sched_group_barrier(0x008, 2, 0);
  };
  for (int kt = 0; kt < nk; ++kt) {
    const char* st = lds + (kt & 1) * 65536;
    ldfrag(st, 0, 0);
    mma(1);
    pat_rd();
    if (kt + 1 < nk) glds(kt + 1, (kt + 1) & 1);
    ldfrag(st, 1, 1);
    mma(0);
    pat_rd();
    ldfrag(st, 2, 0);
    mma(1);
    pat_rd();
    ldfrag(st, 3, 1);
    mma(0);
    pat_rd();
    asm volatile("s_waitcnt vmcnt(0)" ::: "memory");
    __syncthreads();
  }
  mma(1);
}

DI void tile_mn(int t, int Mt, int Nt, int& m, int& n) {
  const int per = 8 * Nt;
  int g = t / per;
  int rem = t - g * per;
  int gs = Mt - g * 8;
  if (gs > 8) gs = 8;
  n = rem / gs;
  m = g * 8 + (rem - n * gs);
}

enum { EPI_INPROJ = 0, EPI_M = 1, EPI_UP = 2, EPI_QKV1 = 3 };

struct GemmArgs {
  const u16* A; int lda; const u16* Bt; int K; int Nt; int layer; u16* Mout;
};

template <int EPI>
DI void phase_gemm(const Params& p, const GemmArgs& ga, char* lds) {
  const int tid = opaque_tid(), lane = tid & 63, w = tid >> 6;
  const int wm = w >> 2, wn = w & 3;
  const int h = lane >> 5, r = lane & 31;
  const int Mt = (EPI == EPI_UP) ? 194 : 192;
  const int total = Mt * ga.Nt;
  for (int it = 0; it * (int)gridDim.x < total; ++it) {
    const int lt = logical_index(it);
    if (lt >= total) continue;
    int mt, nt;
    tile_mn(lt, Mt, ga.Nt, mt, nt);
    int bb, tokbase, S, pos0, rlo = 0, rhi = 256;
    if (EPI == EPI_UP) {
      bb = 0; tokbase = 0; S = NTOK;
      pos0 = 254 * mt - 1;
      rlo = (mt == 0) ? 1 : 0;
      rhi = NTOK - pos0; if (rhi > 256) rhi = 256;
    } else {
      seq_of_token(mt * 256, bb, tokbase, S);
      pos0 = mt * 256 - tokbase;
    }
    const u16* A = ga.A + (ptrdiff_t)(tokbase + pos0) * ga.lda;
    const u16* B = ga.Bt + (size_t)(nt * 256) * ga.K;
    f32x16 acc[4][2];
    bool swap;
    if (EPI == EPI_M) swap = true;
    else if (EPI == EPI_UP) swap = true;
    else if (EPI == EPI_QKV1) swap = (nt < 8);
    else swap = !(nt == 4 || nt == 5);
    if (swap) gemm_mainloop<true>(acc, A, ga.lda, rlo, rhi, B, ga.K, ga.K, lds, (const u16*)(p.ws + OFF_ZERO));
    else gemm_mainloop<false>(acc, A, ga.lda, rlo, rhi, B, ga.K, ga.K, lds, (const u16*)(p.ws + OFF_ZERO));

    const int n0w = nt * 256 + wn * 64;
    if (EPI == EPI_M) {
      u16* mo = ga.Mout + (size_t)(tokbase + pos0 + wm * 128 + r) * DM + n0w + 8 * h;
#pragma unroll
      for (int mi = 0; mi < 4; ++mi)
#pragma unroll
        for (int ni = 0; ni < 2; ++ni)
#pragma unroll
          for (int jp = 0; jp < 2; ++jp) {
            u32x2 X = {pk_bf16(acc[mi][ni][8 * jp], acc[mi][ni][8 * jp + 1]), pk_bf16(acc[mi][ni][8 * jp + 2], acc[mi][ni][8 * jp + 3])};
            u32x2 Y = {pk_bf16(acc[mi][ni][8 * jp + 4], acc[mi][ni][8 * jp + 5]), pk_bf16(acc[mi][ni][8 * jp + 6], acc[mi][ni][8 * jp + 7])};
            half_swap(X, Y);
            u32x4 v = {X.x, X.y, Y.x, Y.y};
            *(u32x4*)(mo + (size_t)(mi * 32) * DM + ni * 32 + 16 * jp) = v;
          }
    } else if (EPI == EPI_QKV1) {
      u16* QK = (u16*)(p.ws + OFF_BIG);
      u16* VT = (u16*)(p.ws + OFF_VT1);
      if (swap) {
        const float sc = (n0w < 1024) ? QK_SCALE_LOG2 : 1.f;
        u16* qo = QK + (size_t)(tokbase + pos0 + wm * 128 + r) * QK1_LD + n0w + 8 * h;
#pragma unroll
        for (int mi = 0; mi < 4; ++mi)
#pragma unroll
          for (int ni = 0; ni < 2; ++ni)
#pragma unroll
            for (int jp = 0; jp < 2; ++jp) {
              u32x2 X = {pk_bf16(acc[mi][ni][8 * jp] * sc, acc[mi][ni][8 * jp + 1] * sc), pk_bf16(acc[mi][ni][8 * jp + 2] * sc, acc[mi][ni][8 * jp + 3] * sc)};
              u32x2 Y = {pk_bf16(acc[mi][ni][8 * jp + 4] * sc, acc[mi][ni][8 * jp + 5] * sc), pk_bf16(acc[mi][ni][8 * jp + 6] * sc, acc[mi][ni][8 * jp + 7] * sc)};
              half_swap(X, Y);
              u32x4 v = {X.x, X.y, Y.x, Y.y};
              *(u32x4*)(qo + (size_t)(mi * 32) * QK1_LD + ni * 32 + 16 * jp) = v;
            }
      } else {
#pragma unroll
        for (int ni = 0; ni < 2; ++ni) {
          const int vrow = n0w - 2048 + ni * 32 + r;
          u16* vb = VT + (size_t)1024 * tokbase + (size_t)vrow * S;
#pragma unroll
          for (int mi = 0; mi < 4; ++mi)
#pragma unroll
            for (int jp = 0; jp < 2; ++jp) {
              const int pos = pos0 + wm * 128 + mi * 32 + 16 * jp + 8 * h;
              u32x2 X = {pk_bf16(acc[mi][ni][8 * jp], acc[mi][ni][8 * jp + 1]), pk_bf16(acc[mi][ni][8 * jp + 2], acc[mi][ni][8 * jp + 3])};
              u32x2 Y = {pk_bf16(acc[mi][ni][8 * jp + 4], acc[mi][ni][8 * jp + 5]), pk_bf16(acc[mi][ni][8 * jp + 6], acc[mi][ni][8 * jp + 7])};
              half_swap(X, Y);
              u32x4 v = {X.x, X.y, Y.x, Y.y};
              *(u32x4*)(vb + pos) = v;
            }
        }
      }
    } else if (EPI == EPI_INPROJ) {
      u16* QK = (u16*)(p.ws + OFF_BIG);
      u16* VT = (u16*)(p.ws + OFF_VT0);
      if (!swap) {
#pragma unroll
        for (int ni = 0; ni < 2; ++ni) {
          const int vrow = (n0w - 1024) + ni * 32 + r;
          u16* vb = VT + (size_t)640 * tokbase + (size_t)vrow * S;
#pragma unroll
          for (int mi = 0; mi < 4; ++mi)
#pragma unroll
            for (int jp = 0; jp < 2; ++jp) {
              const int pos = pos0 + wm * 128 + mi * 32 + 16 * jp + 8 * h;
              u32x2 X = {pk_bf16(acc[mi][ni][8 * jp], acc[mi][ni][8 * jp + 1]), pk_bf16(acc[mi][ni][8 * jp + 2], acc[mi][ni][8 * jp + 3])};
              u32x2 Y = {pk_bf16(acc[mi][ni][8 * jp + 4], acc[mi][ni][8 * jp + 5]), pk_bf16(acc[mi][ni][8 * jp + 6], acc[mi][ni][8 * jp + 7])};
              half_swap(X, Y);
              u32x4 v = {X.x, X.y, Y.x, Y.y};
              *(u32x4*)(vb + pos) = v;
            }
        }
      } else if (n0w >= 2176) {
#pragma unroll
        for (int ni = 0; ni < 2; ++ni)
#pragma unroll
          for (int i = 0; i < 16; ++i) {
            const int vrow = 512 + (n0w - 2176) + ni * 32 + 8 * (i >> 2) + 4 * h + (i & 3);
            u16* vb = VT + (size_t)640 * tokbase + (size_t)vrow * S + pos0 + wm * 128 + r;
#pragma unroll
            for (int mi = 0; mi < 4; ++mi) vb[mi * 32] = to_bf16(acc[mi][ni][i]);
          }
      } else {
        const bool nrm = (n0w >= 1536);
        int dcol;
        const float* gq = p.gqa_qk_g;
        float osc = 1.f;
        if (n0w < 1024) { dcol = n0w; if (n0w < 512) osc = QK_SCALE_LOG2; }
        else if (n0w < 2048) { dcol = 1024 + (n0w - 1536); osc = QK_SCALE_LOG2; }
        else { dcol = 1536 + (n0w - 2048); gq += 64; }
        const float* cs = (const float*)(p.ws + (nrm ? OFF_CS2 : OFF_CS1));
#pragma unroll
        for (int mi = 0; mi < 4; ++mi) {
          const int pos = pos0 + wm * 128 + mi * 32 + r;
          float rs = 1.f;
          if (nrm) {
            float ss = 0.f;
#pragma unroll
            for (int i = 0; i < 16; ++i) ss += acc[mi][0][i] * acc[mi][0][i] + acc[mi][1][i] * acc[mi][1][i];
            ss += __shfl_xor(ss, 32);
            rs = rsqrtf(ss * (1.f / 64.f) + 1e-6f);
          }
          u16* q = QK + (size_t)(tokbase + pos) * QK0_LD + dcol + 8 * h;
          const float* csr = cs + (size_t)pos * 64 + 8 * h;
#pragma unroll
          for (int jp = 0; jp < 2; ++jp) {
            u32x2 v1[2], v2[2];
#pragma unroll
            for (int jj = 0; jj < 2; ++jj) {
              const int j = 2 * jp + jj;
              const float4 ca = *(const float4*)(csr + 16 * j);
              const float4 cb = *(const float4*)(csr + 16 * j + 4);
              float x1[4], x2[4];
#pragma unroll
              for (int e = 0; e < 4; ++e) { x1[e] = acc[mi][0][4 * j + e]; x2[e] = acc[mi][1][4 * j + e]; }
              if (nrm) {
                const float4 ga_ = *(const float4*)(gq + 8 * j + 4 * h);
                const float4 gb_ = *(const float4*)(gq + 32 + 8 * j + 4 * h);
                x1[0] *= rs * ga_.x; x1[1] *= rs * ga_.y; x1[2] *= rs * ga_.z; x1[3] *= rs * ga_.w;
                x2[0] *= rs * gb_.x; x2[1] *= rs * gb_.y; x2[2] *= rs * gb_.z; x2[3] *= rs * gb_.w;
              }
              const float cc[4] = {ca.x, ca.z, cb.x, cb.z};
              const float sn[4] = {ca.y, ca.w, cb.y, cb.w};
              float y1[4], y2[4];
#pragma unroll
              for (int e = 0; e < 4; ++e) {
                y1[e] = (x1[e] * cc[e] - x2[e] * sn[e]) * osc;
                y2[e] = (x2[e] * cc[e] + x1[e] * sn[e]) * osc;
              }
              v1[jj] = (u32x2){pk_bf16(y1[0], y1[1]), pk_bf16(y1[2], y1[3])};
              v2[jj] = (u32x2){pk_bf16(y2[0], y2[1]), pk_bf16(y2[2], y2[3])};
            }
            half_swap(v1[0], v1[1]);
            half_swap(v2[0], v2[1]);
            u32x4 w1 = {v1[0].x, v1[0].y, v1[1].x, v1[1].y};
            u32x4 w2 = {v2[0].x, v2[0].y, v2[1].x, v2[1].y};
            *(u32x4*)(q + 16 * jp) = w1;
            *(u32x4*)(q + 32 + 16 * jp) = w2;
          }
        }
      }
    } else {
      __syncthreads();
      constexpr int RS = 520;
      {
        char* wbase = lds + (wm * 128 + r) * RS + (wn * 64 + 4 * h) * 2;
#pragma unroll
        for (int mi = 0; mi < 4; ++mi)
#pragma unroll
          for (int ni = 0; ni < 2; ++ni)
#pragma unroll
            for (int j = 0; j < 4; ++j) {
              u32x2 v = {pk_bf16(acc[mi][ni][4 * j], acc[mi][ni][4 * j + 1]), pk_bf16(acc[mi][ni][4 * j + 2], acc[mi][ni][4 * j + 3])};
              *(u32x2*)(wbase + mi * 32 * RS + (ni * 32 + 8 * j) * 2) = v;
            }
      }
      __syncthreads();
      {
        const int q4 = tid & 31, seg = tid >> 5;
        const int ch = nt * 128 + 4 * q4;
        const float* cw = p.ffn_conv_w + (size_t)ga.layer * 3 * 5632;
        const float* cb = p.ffn_conv_b + (size_t)ga.layer * 5632;
        float4 wg[3], wv[3];
#pragma unroll
        for (int t3 = 0; t3 < 3; ++t3) { wg[t3] = *(const float4*)(cw + t3 * 5632 + ch); wv[t3] = *(const float4*)(cw + t3 * 5632 + DFF + ch); }
        const float4 bg = *(const float4*)(cb + ch);
        const float4 bv = *(const float4*)(cb + DFF + ch);
        const char* gbase = lds + q4 * 8;
        const char* vbase = lds + 256 + q4 * 8;
        const int R0 = 1 + seg * 16;
        const int Rend = (R0 + 16 < 255) ? (R0 + 16) : 255;
        auto ld4 = [&](const char* b_, int R) -> float4 {
          const u32x2 u = *(const u32x2*)(b_ + R * RS);
          float4 f = {__uint_as_float(u.x << 16), __uint_as_float(u.x & 0xffff0000u), __uint_as_float(u.y << 16), __uint_as_float(u.y & 0xffff0000u)};
          return f;
        };
        float4 pg = ld4(gbase, R0 - 1), pvv = ld4(vbase, R0 - 1);
        float4 cg_ = ld4(gbase, R0), cv_ = ld4(vbase, R0);
        u16* Aout = (u16*)(p.ws + OFF_BIG) + (ptrdiff_t)(tokbase + pos0) * DFF + ch;
#pragma unroll 4
        for (int R = R0; R < Rend; ++R) {
          const float4 ng = ld4(gbase, R + 1), nv = ld4(vbase, R + 1);
          if (pos0 + R < S) {
            const int tflat = pos0 + R;
            const int ps = (tflat < NTOK_P) ? (tflat & (SP - 1)) : ((tflat - NTOK_P) & (SS - 1));
            const int Ss = (tflat < NTOK_P) ? SP : SS;
            const float mp = (ps == 0) ? 0.f : 1.f;
            const float mn = (ps == Ss - 1) ? 0.f : 1.f;
            float g[4], v[4];
            g[0] = mp * pg.x * wg[0].x + cg_.x * wg[1].x + mn * ng.x * wg[2].x + bg.x;
            g[1] = mp * pg.y * wg[0].y + cg_.y * wg[1].y + mn * ng.y * wg[2].y + bg.y;
            g[2] = mp * pg.z * wg[0].z + cg_.z * wg[1].z + mn * ng.z * wg[2].z + bg.z;
            g[3] = mp * pg.w * wg[0].w + cg_.w * wg[1].w + mn * ng.w * wg[2].w + bg.w;
            v[0] = mp * pvv.x * wv[0].x + cv_.x * wv[1].x + mn * nv.x * wv[2].x + bv.x;
            v[1] = mp * pvv.y * wv[0].y + cv_.y * wv[1].y + mn * nv.y * wv[2].y + bv.y;
            v[2] = mp * pvv.z * wv[0].z + cv_.z * wv[1].z + mn * nv.z * wv[2].z + bv.z;
            v[3] = mp * pvv.w * wv[0].w + cv_.w * wv[1].w + mn * nv.w * wv[2].w + bv.w;
            float a_[4];
#pragma unroll
            for (int e = 0; e < 4; ++e) a_[e] = g[e] * __builtin_amdgcn_rcpf(1.f + fexp2(-1.4426950408889634f * g[e])) * v[e];
            u32x2 ov = {pk_bf16(a_[0], a_[1]), pk_bf16(a_[2], a_[3])};
            *(u32x2*)(Aout + (ptrdiff_t)R * DFF) = ov;
          }
          pg = cg_; pvv = cv_; cg_ = ng; cv_ = nv;
        }
      }
    }
  }
}

constexpr int ATT_STAGE = 24576;
template <int DV, bool NA>
DI void flash_pass(f32x16 (&o)[DV / 32], const u16* __restrict__ Qp, const u16* __restrict__ Kb, int ldk,
                   const u16* __restrict__ Vt, int S, int tile0, int ntiles, char* lds, float cscale,
                   int wlo, int whi, const float* bias_lds, int r_w, int qc) {
  const int tid = opaque_tid(), lane = tid & 63;
  const int h = lane >> 5, r = lane & 31;
  bf16x8 q[4];
#pragma unroll
  for (int ks = 0; ks < 4; ++ks) q[ks] = *(const bf16x8*)(Qp + ks * 16 + h * 8);
#pragma unroll
  for (int mv = 0; mv < DV / 32; ++mv)
#pragma unroll
    for (int i = 0; i < 16; ++i) o[mv][i] = 0.f;
  float m_run = -INFINITY, l_run = 0.f;
  const int lr = tid >> 3, lc = tid & 7;
  const int wsw = lr * 128 + ((lc ^ ((lr >> 1) & 7)) << 4);
  u32x4 rk, rv[DV / 64];
  auto gload = [&](int ti) {
    const size_t key0 = (size_t)(tile0 + ti) * 64;
    rk = *(const u32x4*)(Kb + (key0 + lr) * ldk + lc * 8);
#pragma unroll
    for (int i = 0; i < DV / 64; ++i) rv[i] = *(const u32x4*)(Vt + (size_t)(lr + 64 * i) * S + key0 + lc * 8);
  };
  auto swrite = [&](int st) {
    char* ks_ = lds + st * ATT_STAGE;
    *(u32x4*)(ks_ + wsw) = rk;
#pragma unroll
    for (int i = 0; i < DV / 64; ++i) *(u32x4*)(ks_ + 8192 + i * 8192 + wsw) = rv[i];
  };
  const int pr = (r & 0x13) | ((r & 4) << 1) | ((r & 8) >> 1);
  const int ksw = (pr >> 1) & 7;
  const int vsw = (r >> 1) & 7;
  const int cs_ = NA ? min(max(qc - 8, 0), 48) : 0;
  __syncthreads();
  gload(0);
  swrite(0);
  if (ntiles > 1) gload(1);
  __syncthreads();
  for (int ti = 0; ti < ntiles; ++ti) {
    if (ti + 1 < ntiles) {
      swrite((ti + 1) & 1);
      if (ti + 2 < ntiles) gload(ti + 2);
    }
    const char* st = lds + (ti & 1) * ATT_STAGE;
    const bool active = !NA || ((tile0 + ti) >= wlo && (tile0 + ti) <= whi);
    if (active) {
      f32x16 s0, s1;
#pragma unroll
      for (int i = 0; i < 16; ++i) { s0[i] = 0.f; s1[i] = 0.f; }
      {
        bf16x8 ka[4], kb_[4];
#pragma unroll
        for (int ks = 0; ks < 4; ++ks) {
          const int co = ((2 * ks + h) ^ ksw) << 4;
          ka[ks] = *(const bf16x8*)(st + pr * 128 + co);
          kb_[ks] = *(const bf16x8*)(st + (32 + pr) * 128 + co);
        }
        asm volatile("" ::: "memory");
#pragma unroll
        for (int ks = 0; ks < 4; ++ks) {
          s0 = MFMA(ka[ks], q[ks], s0);
          s1 = MFMA(kb_[ks], q[ks], s1);
        }
      }
      bf16x8 vf0[2][DV / 32];
#pragma unroll
      for (int c2 = 0; c2 < 2; ++c2) {
        const int co = ((2 * c2 + h) ^ vsw) << 4;
#pragma unroll
        for (int mv = 0; mv < DV / 32; ++mv) vf0[c2][mv] = *(const bf16x8*)(st + 8192 + (mv * 32 + r) * 128 + co);
      }
      asm volatile("" ::: "memory");
      float t[32];
#pragma unroll
      for (int i = 0; i < 16; ++i) { t[i] = s0[i]; t[16 + i] = s1[i]; }
      if (NA) {
        const int kr = tile0 + ti;
        const int brow = (kr - r_w + 7) * 31;
#pragma unroll
        for (int e = 0; e < 32; ++e) {
          const int i = e & 15, j = i >> 2;
          const int kc = (e >> 4) * 32 + 16 * (j >> 1) + 8 * h + 4 * (j & 1) + (i & 3);
          const bool valid = (kc >= cs_) && (kc < cs_ + 16);
          const int bi = valid ? (brow + kc - qc + 15) : 0;
          const float bv = bias_lds[bi];
          t[e] = valid ? (t[e] + bv) : -INFINITY;
        }
      }
      float mx = t[0];
#pragma unroll
      for (int e = 1; e < 32; ++e) mx = fmaxf(mx, t[e]);
      mx = fmaxf(mx, __shfl_xor(mx, 32));
      if (__builtin_amdgcn_ballot_w64(mx > m_run + 8.f) != 0ull) {
        const float m_new = fmaxf(m_run, mx);
        const float alpha = fexp2(m_run - m_new);
        l_run *= alpha;
        m_run = m_new;
#pragma unroll
        for (int mv = 0; mv < DV / 32; ++mv)
#pragma unroll
          for (int i = 0; i < 16; ++i) o[mv][i] *= alpha;
      }
      float ls = 0.f;
#pragma unroll
      for (int e = 0; e < 32; ++e) { t[e] = fexp2(t[e] - m_run); ls += t[e]; }
      l_run += ls;
      bf16x8 pf[2][2];
#pragma unroll
      for (int kb = 0; kb < 2; ++kb)
#pragma unroll
        for (int c2 = 0; c2 < 2; ++c2) {
          const int e0 = kb * 16 + c2 * 8;
          u32x4 pw = {pk_bf16(t[e0], t[e0 + 1]), pk_bf16(t[e0 + 2], t[e0 + 3]), pk_bf16(t[e0 + 4], t[e0 + 5]), pk_bf16(t[e0 + 6], t[e0 + 7])};
          pf[kb][c2] = __builtin_bit_cast(bf16x8, pw);
        }
      bf16x8 vf1[2][DV / 32];
#pragma unroll
      for (int c2 = 0; c2 < 2; ++c2) {
        const int co = ((4 + 2 * c2 + h) ^ vsw) << 4;
#pragma unroll
        for (int mv = 0; mv < DV / 32; ++mv) vf1[c2][mv] = *(const bf16x8*)(st + 8192 + (mv * 32 + r) * 128 + co);
      }
      asm volatile("" ::: "memory");
#pragma unroll
      for (int c2 = 0; c2 < 2; ++c2)
#pragma unroll
        for (int mv = 0; mv < DV / 32; ++mv) o[mv] = MFMA(vf0[c2][mv], pf[0][c2], o[mv]);
#pragma unroll
      for (int c2 = 0; c2 < 2; ++c2)
#pragma unroll
        for (int mv = 0; mv < DV / 32; ++mv) o[mv] = MFMA(vf1[c2][mv], pf[1][c2], o[mv]);
    }
    __syncthreads();
  }
  const float lt = l_run + __shfl_xor(l_run, 32);
  const float inv = 1.f / lt;
#pragma unroll
  for (int mv = 0; mv < DV / 32; ++mv)
#pragma unroll
    for (int i = 0; i < 16; ++i) o[mv][i] *= inv;
}


DI void flash_pass_q2(f32x16 (&o)[2][2], const u16* __restrict__ Qp0, const u16* __restrict__ Qp1,
                      const u16* __restrict__ Kb, int ldk, const u16* __restrict__ Vt, int S, int ntiles, char* lds) {
  const int tid = opaque_tid(), lane = tid & 63;
  const int h = lane >> 5, r = lane & 31;
  bf16x8 q[2][4];
#pragma unroll
  for (int ks = 0; ks < 4; ++ks) {
    q[0][ks] = *(const bf16x8*)(Qp0 + ks * 16 + h * 8);
    q[1][ks] = *(const bf16x8*)(Qp1 + ks * 16 + h * 8);
  }
#pragma unroll
  for (int hq = 0; hq < 2; ++hq)
#pragma unroll
    for (int mv = 0; mv < 2; ++mv)
#pragma unroll
      for (int i = 0; i < 16; ++i) o[hq][mv][i] = 0.f;
  float m_run[2] = {-INFINITY, -INFINITY}, l_run[2] = {0.f, 0.f};
  const int lr = tid >> 3, lc = tid & 7;
  const int wsw = lr * 128 + ((lc ^ ((lr >> 1) & 7)) << 4);
  u32x4 rk, rv;
  auto gload = [&](int ti) {
    const size_t key0 = (size_t)ti * 64;
    rk = *(const u32x4*)(Kb + (key0 + lr) * ldk + lc * 8);
    rv = *(const u32x4*)(Vt + (size_t)lr * S + key0 + lc * 8);
  };
  auto swrite = [&](int st) {
    char* ks_ = lds + st * ATT_STAGE;
    *(u32x4*)(ks_ + wsw) = rk;
    *(u32x4*)(ks_ + 8192 + wsw) = rv;
  };
  const int pr = (r & 0x13) | ((r & 4) << 1) | ((r & 8) >> 1);
  const int ksw = (pr >> 1) & 7;
  const int vsw = (r >> 1) & 7;
  __syncthreads();
  gload(0);
  swrite(0);
  if (ntiles > 1) gload(1);
  __syncthreads();
  for (int ti = 0; ti < ntiles; ++ti) {
    if (ti + 1 < ntiles) {
      swrite((ti + 1) & 1);
      if (ti + 2 < ntiles) gload(ti + 2);
    }
    const char* st = lds + (ti & 1) * ATT_STAGE;
    f32x16 s[2][2];
#pragma unroll
    for (int hq = 0; hq < 2; ++hq)
#pragma unroll
      for (int kb = 0; kb < 2; ++kb)
#pragma unroll
        for (int i = 0; i < 16; ++i) s[hq][kb][i] = 0.f;
    {
      bf16x8 ka[4], kb_[4];
#pragma unroll
      for (int ks = 0; ks < 4; ++ks) {
        const int co = ((2 * ks + h) ^ ksw) << 4;
        ka[ks] = *(const bf16x8*)(st + pr * 128 + co);
        kb_[ks] = *(const bf16x8*)(st + (32 + pr) * 128 + co);
      }
      asm volatile("" ::: "memory");
#pragma unroll
      for (int ks = 0; ks < 4; ++ks) {
        s[0][0] = MFMA(ka[ks], q[0][ks], s[0][0]);
        s[0][1] = MFMA(kb_[ks], q[0][ks], s[0][1]);
        s[1][0] = MFMA(ka[ks], q[1][ks], s[1][0]);
        s[1][1] = MFMA(kb_[ks], q[1][ks], s[1][1]);
      }
    }
    bf16x8 pf[2][2][2];
#pragma unroll
    for (int hq = 0; hq < 2; ++hq) {
      float t[32];
#pragma unroll
      for (int i = 0; i < 16; ++i) { t[i] = s[hq][0][i]; t[16 + i] = s[hq][1][i]; }
      float mx = t[0];
#pragma unroll
      for (int e = 1; e < 32; ++e) mx = fmaxf(mx, t[e]);
      mx = fmaxf(mx, __shfl_xor(mx, 32));
      if (__builtin_amdgcn_ballot_w64(mx > m_run[hq] + 8.f) != 0ull) {
        const float m_new = fmaxf(m_run[hq], mx);
        const float alpha = fexp2(m_run[hq] - m_new);
        l_run[hq] *= alpha;
        m_run[hq] = m_new;
#pragma unroll
        for (int mv = 0; mv < 2; ++mv)
#pragma unroll
          for (int i = 0; i < 16; ++i) o[hq][mv][i] *= alpha;
      }
      float ls = 0.f;
#pragma unroll
      for (int e = 0; e < 32; ++e) { t[e] = fexp2(t[e] - m_run[hq]); ls += t[e]; }
      l_run[hq] += ls;
#pragma unroll
      for (int kb = 0; kb < 2; ++kb)
#pragma unroll
        for (int c2 = 0; c2 < 2; ++c2) {
          const int e0 = kb * 16 + c2 * 8;
          u32x4 pw = {pk_bf16(t[e0], t[e0 + 1]), pk_bf16(t[e0 + 2], t[e0 + 3]), pk_bf16(t[e0 + 4], t[e0 + 5]), pk_bf16(t[e0 + 6], t[e0 + 7])};
          pf[hq][kb][c2] = __builtin_bit_cast(bf16x8, pw);
        }
    }
    bf16x8 vf[2][2][2];
#pragma unroll
    for (int kb = 0; kb < 2; ++kb)
#pragma unroll
      for (int c2 = 0; c2 < 2; ++c2) {
        const int co = ((4 * kb + 2 * c2 + h) ^ vsw) << 4;
#pragma unroll
        for (int mv = 0; mv < 2; ++mv) vf[kb][c2][mv] = *(const bf16x8*)(st + 8192 + (mv * 32 + r) * 128 + co);
      }
    asm volatile("" ::: "memory");
#pragma unroll
    for (int kb = 0; kb < 2; ++kb)
#pragma unroll
      for (int c2 = 0; c2 < 2; ++c2)
#pragma unroll
        for (int mv = 0; mv < 2; ++mv) {
          o[0][mv] = MFMA(vf[kb][c2][mv], pf[0][kb][c2], o[0][mv]);
          o[1][mv] = MFMA(vf[kb][c2][mv], pf[1][kb][c2], o[1][mv]);
        }
    __syncthreads();
  }
#pragma unroll
  for (int hq = 0; hq < 2; ++hq) {
    const float lt = l_run[hq] + __shfl_xor(l_run[hq], 32);
    const float inv = 1.f / lt;
#pragma unroll
    for (int mv = 0; mv < 2; ++mv)
#pragma unroll
      for (int i = 0; i < 16; ++i) o[hq][mv][i] *= inv;
  }
}

DI void flash_pass_na(f32x16 (&o)[2], const u16* __restrict__ Qp, const u16* __restrict__ Kb, int ldk,
                      const u16* __restrict__ Vt, int S, int tile0, int ntiles, char* lds, int wlo, int whi,
                      const float* bias_lds, int qrow, int rs_q, int qcol, int cs0) {
  const int tid = opaque_tid(), lane = tid & 63;
  const int h = lane >> 5, r = lane & 31;
  bf16x8 q[4];
#pragma unroll
  for (int ks = 0; ks < 4; ++ks) q[ks] = *(const bf16x8*)(Qp + ks * 16 + h * 8);
#pragma unroll
  for (int mv = 0; mv < 2; ++mv)
#pragma unroll
    for (int i = 0; i < 16; ++i) o[mv][i] = 0.f;
  float m_run = -1e30f, l_run = 0.f;
  const int lr = tid >> 3, lc = tid & 7;
  const int wsw = lr * 128 + ((lc ^ ((lr >> 1) & 7)) << 4);
  u32x4 rk, rv;
  auto gload = [&](int ti) {
    const size_t key0 = (size_t)(tile0 + ti) * 64;
    rk = *(const u32x4*)(Kb + (key0 + lr) * ldk + lc * 8);
    rv = *(const u32x4*)(Vt + (size_t)lr * S + key0 + lc * 8);
  };
  auto swrite = [&](int st) {
    char* ks_ = lds + st * ATT_STAGE;
    *(u32x4*)(ks_ + wsw) = rk;
    *(u32x4*)(ks_ + 8192 + wsw) = rv;
  };
  const int pr = (r & 0x13) | ((r & 4) << 1) | ((r & 8) >> 1);
  const int krow = cs0 + pr;
  const int ksw = (krow >> 1) & 7;
  const int vsw = (r >> 1) & 7;
  const int vch0 = cs0 >> 3;
  const int csq = min(max(qcol - 8, 0), 48);
  bool navalid[16];
#pragma unroll
  for (int i = 0; i < 16; ++i) {
    const int j = i >> 2;
    const int kc = cs0 + 16 * (j >> 1) + 8 * h + 4 * (j & 1) + (i & 3);
    navalid[i] = (unsigned)(kc - csq) < 16u;
  }
  const int dcb = cs0 + 8 * h - qcol + 15;
  __syncthreads();
  gload(0);
  swrite(0);
  if (ntiles > 1) gload(1);
  __syncthreads();
  for (int ti = 0; ti < ntiles; ++ti) {
    if (ti + 1 < ntiles) {
      swrite((ti + 1) & 1);
      if (ti + 2 < ntiles) gload(ti + 2);
    }
    const char* st = lds + (ti & 1) * ATT_STAGE;
    const int kr = tile0 + ti;
    if (kr >= wlo && kr <= whi) {
      f32x16 s0;
#pragma unroll
      for (int i = 0; i < 16; ++i) s0[i] = 0.f;
      {
        bf16x8 ka[4];
#pragma unroll
        for (int ks = 0; ks < 4; ++ks) ka[ks] = *(const bf16x8*)(st + krow * 128 + (((2 * ks + h) ^ ksw) << 4));
        asm volatile("" ::: "memory");
#pragma unroll
        for (int ks = 0; ks < 4; ++ks) s0 = MFMA(ka[ks], q[ks], s0);
      }
      bf16x8 vf[2][2];
#pragma unroll
      for (int c2 = 0; c2 < 2; ++c2) {
        const int co = ((vch0 + 2 * c2 + h) ^ vsw) << 4;
#pragma unroll
        for (int mv = 0; mv < 2; ++mv) vf[c2][mv] = *(const bf16x8*)(st + 8192 + (mv * 32 + r) * 128 + co);
      }
      asm volatile("" ::: "memory");
      const bool rowok = (kr >= rs_q) && (kr <= rs_q + 7);
      const int bidx = rowok ? ((kr - qrow + 7) * 31 + dcb) : 64;
      float t[16];
#pragma unroll
      for (int i = 0; i < 16; ++i) {
        const int j = i >> 2;
        const int kco = 16 * (j >> 1) + 4 * (j & 1) + (i & 3);
        const bool ok = navalid[i] && rowok;
        const float bv = bias_lds[ok ? (bidx + kco) : 0];
        t[i] = ok ? (s0[i] + bv) : -INFINITY;
      }
      float mx = t[0];
#pragma unroll
      for (int e = 1; e < 16; ++e) mx = fmaxf(mx, t[e]);
      mx = fmaxf(mx, __shfl_xor(mx, 32));
      if (__builtin_amdgcn_ballot_w64(mx > m_run + 8.f) != 0ull) {
        const float m_new = fmaxf(m_run, mx);
        const float alpha = fexp2(m_run - m_new);
        l_run *= alpha;
        m_run = m_new;
#pragma unroll
        for (int mv = 0; mv < 2; ++mv)
#pragma unroll
          for (int i = 0; i < 16; ++i) o[mv][i] *= alpha;
      }
      float ls = 0.f;
#pragma unroll
      for (int e = 0; e < 16; ++e) { t[e] = fexp2(t[e] - m_run); ls += t[e]; }
      l_run += ls;
#pragma unroll
      for (int c2 = 0; c2 < 2; ++c2) {
        const int e0 = c2 * 8;
        u32x4 pw = {pk_bf16(t[e0], t[e0 + 1]), pk_bf16(t[e0 + 2], t[e0 + 3]), pk_bf16(t[e0 + 4], t[e0 + 5]), pk_bf16(t[e0 + 6], t[e0 + 7])};
        const bf16x8 pf = __builtin_bit_cast(bf16x8, pw);
#pragma unroll
        for (int mv = 0; mv < 2; ++mv) o[mv] = MFMA(vf[c2][mv], pf, o[mv]);
      }
    }
    __syncthreads();
  }
  const float lt = l_run + __shfl_xor(l_run, 32);
  const float inv = 1.f / lt;
#pragma unroll
  for (int mv = 0; mv < 2; ++mv)
#pragma unroll
    for (int i = 0; i < 16; ++i) o[mv][i] *= inv;
}

DI void phase_attn0(const Params& p, char* lds) {
  const int tid = opaque_tid(), lane = tid & 63, w = tid >> 6;
  const int h = lane >> 5, r = lane & 31;
  const u16* QK = (const u16*)(p.ws + OFF_BIG);
  const u16* VT = (const u16*)(p.ws + OFF_VT0);
  u16* O = (u16*)(p.ws + OFF_H);
  float* stash = (float*)(p.ws + OFF_STASH) + (((size_t)blockIdx.x * 8 + w) * 64 + lane) * 64;
  float lam;
  {
    const float* lf = p.diff_lambda;
    float a = lf[lane] * lf[64 + lane];
    float b = lf[128 + lane] * lf[192 + lane];
#pragma unroll
    for (int o_ = 1; o_ < 64; o_ <<= 1) { a += __shfl_xor(a, o_); b += __shfl_xor(b, o_); }
    lam = __expf(a) - __expf(b) + 0.2f;
  }
  const int total = 1536;
  const int G = gridDim.x;
  const bool dyn = ((G & 7) == 0);
  unsigned* qhead = (unsigned*)(p.ws + OFF_BAR + 256 * (1 + (blockIdx.x & 7)));
  volatile int* qslot = (volatile int*)(lds + 2 * ATT_STAGE + 4096);
  for (int it0 = 0;; ++it0) {
    int lt;
    if (dyn) {
      __syncthreads();
      if (tid == 0) *qslot = (int)__hip_atomic_fetch_add(qhead, 1u, __ATOMIC_RELAXED, __HIP_MEMORY_SCOPE_AGENT);
      __syncthreads();
      const int k = *qslot;
      const int per = G >> 3;
      const int it = k / per;
      if (it * G >= total) break;
      lt = it * G + (blockIdx.x & 7) * per + (k - it * per);
    } else {
      if (it0 * G >= total) break;
      lt = it0 * G + blockIdx.x;
    }
    if (lt >= total) continue;
    int cls, bb, head, qb, S, tokbase;
    if (lt < 512) { cls = 0; bb = lt >> 8; head = (lt >> 6) & 3; qb = lt & 63; }
    else if (lt < 1024) { int u = lt - 512; cls = 1; bb = u >> 8; head = (u >> 6) & 3; qb = u & 63; }
    else if (lt < 1280) { int u = lt - 1024; cls = 0; bb = 2 + (u >> 5); head = (u >> 3) & 3; qb = u & 7; }
    else { int u = lt - 1280; cls = 1; bb = 2 + (u >> 5); head = (u >> 3) & 3; qb = u & 7; }
    if (bb < 2) { S = SP; tokbase = bb * SP; } else { S = SS; tokbase = NTOK_P + (bb - 2) * SS; }
    const int tq = tokbase + qb * 256 + w * 32 + r;
    const u16* Kseq = QK + (size_t)tokbase * QK0_LD;
    const u16* Vseq = VT + (size_t)640 * tokbase;
    if (cls == 0) {
      f32x16 o[4];
#pragma unroll 1
      for (int comp = 0; comp < 2; ++comp) {
        const int hc = head * 2 + comp;
        flash_pass<128, false>(o, QK + (size_t)tq * QK0_LD + hc * 64, Kseq + 512 + hc * 64, QK0_LD,
                               Vseq + (size_t)(head * 128) * S, S, 0, S >> 6, lds, QK_SCALE_LOG2, 0, 0, nullptr, 0, 0);
        if (comp == 0) {
#pragma unroll
          for (int mv = 0; mv < 4; ++mv) {
#pragma unroll
            for (int i = 0; i < 4; ++i) {
              float4 v4 = {o[mv][4 * i], o[mv][4 * i + 1], o[mv][4 * i + 2], o[mv][4 * i + 3]};
              *(float4*)(stash + mv * 16 + i * 4) = v4;
            }
            asm volatile("" ::: "memory");
          }
        }
      }
      float ss = 0.f;
#pragma unroll
      for (int mv = 0; mv < 4; ++mv) {
#pragma unroll
        for (int i = 0; i < 4; ++i) {
          const float4 s4 = *(const float4*)(stash + mv * 16 + i * 4);
          float v;
          v = s4.x - lam * o[mv][4 * i]; o[mv][4 * i] = v; ss += v * v;
          v = s4.y - lam * o[mv][4 * i + 1]; o[mv][4 * i + 1] = v; ss += v * v;
          v = s4.z - lam * o[mv][4 * i + 2]; o[mv][4 * i + 2] = v; ss += v * v;
          v = s4.w - lam * o[mv][4 * i + 3]; o[mv][4 * i + 3] = v; ss += v * v;
        }
        asm volatile("" ::: "memory");
      }
      ss += __shfl_xor(ss, 32);
      const float rs = rsqrtf(ss * (1.f / 128.f) + 1e-5f) * 0.8f;
      u16* orow = O + (size_t)tq * DM + head * 128;
#pragma unroll
      for (int mv = 0; mv < 4; ++mv) {
#pragma unroll
        for (int jp = 0; jp < 2; ++jp) {
          u32x2 XY[2];
#pragma unroll
          for (int jj = 0; jj < 2; ++jj) {
            const int j = 2 * jp + jj;
            const float4 g = *(const float4*)(p.diff_subln_g + mv * 32 + 8 * j + 4 * h);
            XY[jj] = (u32x2){pk_bf16(o[mv][4 * j] * rs * g.x, o[mv][4 * j + 1] * rs * g.y),
                             pk_bf16(o[mv][4 * j + 2] * rs * g.z, o[mv][4 * j + 3] * rs * g.w)};
          }
          half_swap(XY[0], XY[1]);
          u32x4 v = {XY[0].x, XY[0].y, XY[1].x, XY[1].y};
          *(u32x4*)(orow + mv * 32 + 16 * jp + 8 * h) = v;
        }
        asm volatile("" ::: "memory");
      }
    } else {
      f32x16 o[2][2];
      const int kvh = head >> 1;
      const u16* qrow = QK + (size_t)tq * QK0_LD + 1024 + (2 * head) * 64;
      flash_pass_q2(o, qrow, qrow + 64, Kseq + 1536 + kvh * 64, QK0_LD, Vseq + (size_t)(512 + kvh * 64) * S, S, S >> 6, lds);
#pragma unroll
      for (int hq = 0; hq < 2; ++hq) {
        u16* orow = O + (size_t)tq * DM + 512 + (2 * head + hq) * 64;
#pragma unroll
        for (int mv = 0; mv < 2; ++mv)
#pragma unroll
          for (int jp = 0; jp < 2; ++jp) {
            u32x2 X = {pk_bf16(o[hq][mv][8 * jp], o[hq][mv][8 * jp + 1]), pk_bf16(o[hq][mv][8 * jp + 2], o[hq][mv][8 * jp + 3])};
            u32x2 Y = {pk_bf16(o[hq][mv][8 * jp + 4], o[hq][mv][8 * jp + 5]), pk_bf16(o[hq][mv][8 * jp + 6], o[hq][mv][8 * jp + 7])};
            half_swap(X, Y);
            u32x4 v = {X.x, X.y, Y.x, Y.y};
            *(u32x4*)(orow + mv * 32 + 16 * jp + 8 * h) = v;
          }
      }
    }
  }
}

DI void phase_na(const Params& p, char* lds) {
  const int tid = opaque_tid(), lane = tid & 63, w = tid >> 6;
  const int h = lane >> 5, r = lane & 31;
  const u16* QK = (const u16*)(p.ws + OFF_BIG);
  const u16* VT = (const u16*)(p.ws + OFF_VT1);
  u16* O = (u16*)(p.ws + OFF_H);
  float* bias = (float*)(lds + 2 * ATT_STAGE);
  const int total = 3072;
  for (int it = 0; it * (int)gridDim.x < total; ++it) {
    const int lt = logical_index(it);
    if (lt >= total) continue;
    int bb, head, r4, S, tokbase, rows;
    if (lt < 2048) { bb = lt >> 10; head = (lt >> 6) & 15; r4 = lt & 63; S = SP; tokbase = bb * SP; rows = 256; }
    else { int u = lt - 2048; bb = 2 + (u >> 7); head = (u >> 3) & 15; r4 = u & 7; S = SS; tokbase = NTOK_P + (bb - 2) * SS; rows = 32; }
    __syncthreads();
    for (int e = tid; e < 465; e += NTHR) bias[e] = p.odd_rpb[head * 465 + e] * 1.4426950408889634f;
    const int rfirst = r4 * 4, rlast = r4 * 4 + 3;
    const int rs_first = min(max(rfirst - 4, 0), rows - 8);
    const int rs_last = min(max(rlast - 4, 0), rows - 8);
    const int ntiles = rs_last + 8 - rs_first;
    const int rp0 = rfirst + 2 * (w >> 2);
    const int cq = w & 3;
    const int qrow = rp0 + (r >> 4);
    const int qcol = 16 * cq + (r & 15);
    const int rs_q = min(max(qrow - 4, 0), rows - 8);
    const int wlo = min(max(rp0 - 4, 0), rows - 8);
    const int whi = min(max(rp0 + 1 - 4, 0), rows - 8) + 7;
    const int cs0 = min(max(16 * cq - 8, 0), 32);
    const int tq = tokbase + qrow * 64 + qcol;
    f32x16 o[2];
    flash_pass_na(o, QK + (size_t)tq * QK1_LD + head * 64, QK + (size_t)tokbase * QK1_LD + 1024 + head * 64, QK1_LD,
                  VT + (size_t)1024 * tokbase + (size_t)(head * 64) * S, S, rs_first, ntiles, lds,
                  wlo, whi, bias, qrow, rs_q, qcol, cs0);
    u16* orow = O + (size_t)tq * DM + head * 64;
#pragma unroll
    for (int mv = 0; mv < 2; ++mv)
#pragma unroll
      for (int jp = 0; jp < 2; ++jp) {
        u32x2 X = {pk_bf16(o[mv][8 * jp], o[mv][8 * jp + 1]), pk_bf16(o[mv][8 * jp + 2], o[mv][8 * jp + 3])};
        u32x2 Y = {pk_bf16(o[mv][8 * jp + 4], o[mv][8 * jp + 5]), pk_bf16(o[mv][8 * jp + 6], o[mv][8 * jp + 7])};
        half_swap(X, Y);
        u32x4 v = {X.x, X.y, Y.x, Y.y};
        *(u32x4*)(orow + mv * 32 + 16 * jp + 8 * h) = v;
      }
  }
}

DI void grid_barrier(unsigned* ctr, unsigned target) {
  asm volatile("s_waitcnt vmcnt(0)" ::: "memory");
  __syncthreads();
  if (threadIdx.x == 0) {
    __builtin_amdgcn_fence(__ATOMIC_RELEASE, "agent");
    asm volatile("s_waitcnt vmcnt(0)" ::: "memory");
    __hip_atomic_fetch_add(ctr, 1u, __ATOMIC_RELAXED, __HIP_MEMORY_SCOPE_AGENT);
    while (__hip_atomic_load(ctr, __ATOMIC_RELAXED, __HIP_MEMORY_SCOPE_AGENT) < target) __builtin_amdgcn_s_sleep(1);
    __builtin_amdgcn_fence(__ATOMIC_ACQUIRE, "agent");
    asm volatile("s_waitcnt vmcnt(0)" ::: "memory");
  }
  __syncthreads();
}

__global__ void __launch_bounds__(NTHR) mega(Params p, int ph0, int ph1) {
  __shared__ __attribute__((aligned(16))) char lds[LDS_BYTES];
  unsigned* bar = (unsigned*)(p.ws + OFF_BAR);
  if (ph0 == 0 && blockIdx.x == 0 && threadIdx.x < 9)
    __hip_atomic_store((unsigned*)(p.ws + OFF_BAR + 256 * threadIdx.x), 0u, __ATOMIC_RELAXED, __HIP_MEMORY_SCOPE_AGENT);
  if (ph0 == 0 && blockIdx.x == 0 && threadIdx.x >= 64 && threadIdx.x < 128) ((unsigned*)(p.ws + OFF_ZERO))[threadIdx.x - 64] = 0u;
  unsigned nbar = 0;
  for (int ph = ph0; ph < ph1; ++ph) {
    if (ph > ph0) {
      if (ph == ph0 + 1) cg::this_grid().sync();
      else { ++nbar; grid_barrier(bar, nbar * gridDim.x); }
    }
    const u16* H = (const u16*)(p.ws + OFF_H);
    u16* Hm = (u16*)(p.ws + OFF_H);
    const u16* Abuf = (const u16*)(p.ws + OFF_BIG);
    u16* Bm = (u16*)(p.ws + OFF_BIG);
    switch (ph) {
      case 0:
        for (int item = blockIdx.x; item < 6528; item += gridDim.x) phase0_item(p, item, lds);
        break;
      case 1: phase_ln(p, 0, 0, true, false, nullptr, 0, 0); break;
      case 2: { GemmArgs ga{H, DM, (const u16*)(p.ws + OFF_WT_IN), 1024, 9, 0, nullptr}; phase_gemm<EPI_INPROJ>(p, ga, lds); } break;
      case 3: phase_attn0(p, lds); break;
      case 5: phase_ln(p, 0, 1, true, false, Abuf, 0, 2048); break;
      case 6: { GemmArgs ga{H, DM, (const u16*)(p.ws + OFF_WT_UP0), 1024, 22, 0, nullptr}; phase_gemm<EPI_UP>(p, ga, lds); } break;
      case 8: phase_ln(p, 1, 0, false, false, H, 0, 5120); break;
      case 9: { GemmArgs ga{H, DM, (const u16*)(p.ws + OFF_WT_QKV), 1024, 12, 1, nullptr}; phase_gemm<EPI_QKV1>(p, ga, lds); } break;
      case 10: phase_na(p, lds); break;
      case 12: phase_ln(p, 1, 1, false, false, Abuf, 1, 2048); break;
      case 13: { GemmArgs ga{H, DM, (const u16*)(p.ws + OFF_WT_UP1), 1024, 22, 1, nullptr}; phase_gemm<EPI_UP>(p, ga, lds); } break;
      case 15: phase_ln(p, 0, 0, false, true, H, 1, 5120); break;
      case 4: case 7: case 11: case 14: {
        GemmArgs ga;
        if (ph == 4) ga = GemmArgs{H, DM, (const u16*)(p.ws + OFF_WT_OUT0), 1024, 4, 0, Bm};
        else if (ph == 7) ga = GemmArgs{Abuf, DFF, (const u16*)(p.ws + OFF_WT_DN0), 2816, 4, 0, Hm};
        else if (ph == 11) ga = GemmArgs{H, DM, (const u16*)(p.ws + OFF_WT_OUT1), 1024, 4, 1, Bm};
        else ga = GemmArgs{Abuf, DFF, (const u16*)(p.ws + OFF_WT_DN1), 2816, 4, 1, Hm};
        phase_gemm<EPI_M>(p, ga, lds);
      } break;
      default: break;
    }
  }
}

extern "C" void kernel_launch(void* const* d_in, const int* in_sizes, int n_in, void* d_out, int out_size,
                              void* d_ws, size_t ws_size, hipStream_t stream) {
  static int grid_blocks = 0;
  if (!grid_blocks) {
    int dev = 0, cus = 0, per_cu = 0;
    hipGetDevice(&dev);
    hipDeviceGetAttribute(&cus, hipDeviceAttributeMultiprocessorCount, dev);
    hipOccupancyMaxActiveBlocksPerMultiprocessor(&per_cu, mega, NTHR, 0);
    if (per_cu < 1) per_cu = 1;
    if (per_cu > 1) per_cu = 1;
    grid_blocks = cus * per_cu;
    if (grid_blocks > 256) grid_blocks = 256;
    if (grid_blocks < 1) grid_blocks = 1;
  }
  if (ws_size < WS_NEEDED) fprintf(stderr, "workspace too small: %zu < %zu\n", ws_size, (size_t)WS_NEEDED);
  Params p{};
  p.x_prompt = (const float*)d_in[0]; p.x_sample = (const float*)d_in[1];
  p.c_prompt = (const float*)d_in[2]; p.c_sample = (const float*)d_in[3];
  p.ada_w = (const float*)d_in[4]; p.ada_b = (const float*)d_in[5]; p.norm_g = (const float*)d_in[6];
  p.even_w_in = (const float*)d_in[7]; p.even_w_out = (const float*)d_in[8];
  p.diff_lambda = (const float*)d_in[9]; p.diff_subln_g = (const float*)d_in[10]; p.gqa_qk_g = (const float*)d_in[11];
  p.odd_w_qkv = (const float*)d_in[12]; p.odd_rpb = (const float*)d_in[13]; p.odd_w_out = (const float*)d_in[14];
  p.ffn_w_up = (const float*)d_in[15]; p.ffn_conv_w = (const float*)d_in[16]; p.ffn_conv_b = (const float*)d_in[17];
  p.ffn_w_down = (const float*)d_in[18]; p.final_g = (const float*)d_in[19];
  p.out = (float*)d_out;
  p.ws = (char*)d_ws;
#if ONE_LAUNCH
  int ph0 = 0, ph1 = NPHASE;
  void* args[] = {&p, &ph0, &ph1};
  hipError_t e = hipLaunchCooperativeKernel((void*)mega, dim3(grid_blocks), dim3(NTHR), args, 0, stream);
  if (e != hipSuccess) fprintf(stderr, "cooperative launch failed: %s (grid %d)\n", hipGetErrorString(e), grid_blocks);
#else
  for (int ph = 0; ph < NPHASE; ++ph) mega<<<dim3(grid_blocks), dim3(NTHR), 0, stream>>>(p, ph, ph + 1);
#endif
}
```

```cpp
#include <hip/hip_runtime.h>
#include <hip/hip_cooperative_groups.h>
#include <cstdio>
namespace cg = cooperative_groups;

typedef unsigned short u16;
typedef __attribute__((ext_vector_type(8))) short bf16x8;
typedef __attribute__((ext_vector_type(16))) float f32x16;
typedef __attribute__((ext_vector_type(4))) unsigned u32x4;
typedef __attribute__((ext_vector_type(2))) unsigned u32x2;
typedef __attribute__((ext_vector_type(2))) float f32x2;
typedef __attribute__((ext_vector_type(2))) __bf16 bf16v2;
typedef __attribute__((ext_vector_type(4))) float f32x4v;

#define DI __device__ __forceinline__
#define MFMA(a, b, c) __builtin_amdgcn_mfma_f32_32x32x16_bf16((a), (b), (c), 0, 0, 0)

#ifndef ONE_LAUNCH
#define ONE_LAUNCH 1
#endif

constexpr int NTHR = 512;
constexpr int DM = 1024;
constexpr int NTOK = 49152;
constexpr int NTOK_P = 32768;
constexpr int SP = 16384, SS = 2048;
constexpr int DFF = 2816;
constexpr int QK0_LD = 1664;
constexpr int QK1_LD = 2048;
constexpr int NPHASE = 16;

constexpr size_t OFF_WT_IN = 0;
constexpr size_t OFF_WT_OUT0 = OFF_WT_IN + (size_t)2304 * 1024 * 2;
constexpr size_t OFF_WT_UP0 = OFF_WT_OUT0 + (size_t)1024 * 1024 * 2;
constexpr size_t OFF_WT_UP1 = OFF_WT_UP0 + (size_t)5632 * 1024 * 2;
constexpr size_t OFF_WT_DN0 = OFF_WT_UP1 + (size_t)5632 * 1024 * 2;
constexpr size_t OFF_WT_DN1 = OFF_WT_DN0 + (size_t)1024 * 2816 * 2;
constexpr size_t OFF_WT_QKV = OFF_WT_DN1 + (size_t)1024 * 2816 * 2;
constexpr size_t OFF_WT_OUT1 = OFF_WT_QKV + (size_t)3072 * 1024 * 2;
constexpr size_t OFF_MOD = OFF_WT_OUT1 + (size_t)1024 * 1024 * 2;
constexpr size_t OFF_CS1 = OFF_MOD + (size_t)2 * 10 * 6144 * 4;
constexpr size_t OFF_CS2 = OFF_CS1 + (size_t)16384 * 32 * 8;
constexpr size_t OFF_H = OFF_CS2 + (size_t)16384 * 32 * 8;
constexpr size_t OFF_BIG = OFF_H + (size_t)NTOK * 1024 * 2;
constexpr size_t BIG_BYTES = (size_t)NTOK * 3072 * 2;
constexpr size_t OFF_VT0 = OFF_BIG + (size_t)NTOK * QK0_LD * 2;
constexpr size_t OFF_VT1 = OFF_BIG + (size_t)NTOK * QK1_LD * 2;
constexpr size_t OFF_STASH = OFF_BIG + BIG_BYTES;
constexpr size_t STASH_PER_BLOCK = (size_t)8 * 64 * 64 * 4;
constexpr size_t OFF_BAR = OFF_STASH + 256 * STASH_PER_BLOCK;
constexpr size_t OFF_ZERO = OFF_BAR + 4096;
constexpr size_t WS_NEEDED = OFF_ZERO + 256;

constexpr int LDS_BYTES = 133120;
constexpr float QK_SCALE_LOG2 = 0.125f * 1.4426950408889634f;

__device__ const float INV1[32] = {1.000000000e+00f, 7.498942614e-01f, 5.623413324e-01f, 4.216965139e-01f, 3.162277639e-01f, 2.371373773e-01f, 1.778279394e-01f, 1.333521307e-01f, 1.000000015e-01f, 7.498941571e-02f, 5.623413250e-02f, 4.216965288e-02f, 3.162277490e-02f, 2.371373773e-02f, 1.778279431e-02f, 1.333521493e-02f, 9.999999776e-03f, 7.498941850e-03f, 5.623413250e-03f, 4.216964822e-03f, 3.162277630e-03f, 2.371373586e-03f, 1.778279431e-03f, 1.333521446e-03f, 1.000000047e-03f, 7.498942432e-04f, 5.623413017e-04f, 4.216965172e-04f, 3.162277571e-04f, 2.371373703e-04f, 1.778279402e-04f, 1.333521504e-04f};
__device__ const float INV2[16] = {1.000000000e+00f, 5.623413324e-01f, 3.162277639e-01f, 1.778279394e-01f, 1.000000015e-01f, 5.623413250e-02f, 3.162277490e-02f, 1.778279431e-02f, 9.999999776e-03f, 5.623413250e-03f, 3.162277630e-03f, 1.778279431e-03f, 1.000000047e-03f, 5.623413017e-04f, 3.162277571e-04f, 1.778279402e-04f};

struct Params {
  const float *x_prompt, *x_sample, *c_prompt, *c_sample, *ada_w, *ada_b, *norm_g, *even_w_in, *even_w_out,
      *diff_lambda, *diff_subln_g, *gqa_qk_g, *odd_w_qkv, *odd_rpb, *odd_w_out, *ffn_w_up, *ffn_conv_w,
      *ffn_conv_b, *ffn_w_down, *final_g;
  float* out;
  char* ws;
};

DI unsigned pk_bf16(float a, float b) {
  f32x2 v = {a, b};
  bf16v2 r = __builtin_convertvector(v, bf16v2);
  return __builtin_bit_cast(unsigned, r);
}
DI u16 to_bf16(float a) { return (u16)(pk_bf16(a, 0.f) & 0xffffu); }
DI float bf16_to_f(u16 v) { return __uint_as_float(((unsigned)v) << 16); }
DI void half_swap(u32x2& X, u32x2& Y) {
  typedef __attribute__((ext_vector_type(2))) unsigned u2_;
  const u2_ a = __builtin_amdgcn_permlane32_swap(X.x, Y.x, false, false);
  const u2_ b = __builtin_amdgcn_permlane32_swap(X.y, Y.y, false, false);
  X.x = a.x; Y.x = a.y; X.y = b.x; Y.y = b.y;
}
DI int opaque_tid() { int t = threadIdx.x; asm volatile("" : "+v"(t)); return t; }
DI float fexp2(float x) { return __builtin_amdgcn_exp2f(x); }
DI int swz(int row, int chunk) { return row * 128 + ((chunk ^ ((row >> 1) & 7)) << 4); }
DI int crow(int i, int h) { return (i & 3) + 8 * (i >> 2) + 4 * h; }
DI void seq_of_token(int t, int& bb, int& tokbase, int& S) {
  if (t < NTOK_P) { bb = t >> 14; tokbase = bb << 14; S = SP; }
  else { int u = (t - NTOK_P) >> 11; bb = 2 + u; tokbase = NTOK_P + (u << 11); S = SS; }
}
DI const float* xin_row(const Params& p, int t) {
  return (t < NTOK_P) ? (p.x_prompt + (size_t)t * DM) : (p.x_sample + (size_t)(t - NTOK_P) * DM);
}
DI int logical_index(int it) {
  const int G = gridDim.x, b = blockIdx.x;
  if ((G & 7) == 0) return it * G + (b & 7) * (G >> 3) + (b >> 3);
  return it * G + b;
}

DI void phase0_item(const Params& p, int item, char* lds) {
  const int tid = opaque_tid();
  if (item < 192) {
    const int l = item / 96, jc = item % 96;
    float* cact = (float*)lds;
    float* red = (float*)(lds + 40960);
    for (int e = tid; e < 10240; e += NTHR) {
      int bb = e >> 10, k = e & 1023;
      float c = (bb < 2) ? p.c_prompt[bb * 1024 + k] : p.c_sample[(bb - 2) * 1024 + k];
      cact[e] = c / (1.f + __expf(-c));
    }
    __syncthreads();
    const int c4 = tid & 15, kg = tid >> 4;
    float4 acc[10];
#pragma unroll
    for (int b = 0; b < 10; ++b) acc[b] = (float4){0.f, 0.f, 0.f, 0.f};
    const float* w = p.ada_w + (size_t)l * 1024 * 6144 + (size_t)(kg * 32) * 6144 + jc * 64 + c4 * 4;
#pragma unroll 8
    for (int k = 0; k < 32; ++k) {
      const float4 wv = *(const float4*)(w + (size_t)k * 6144);
#pragma unroll
      for (int b = 0; b < 10; ++b) {
        const float cv = cact[b * 1024 + kg * 32 + k];
        acc[b].x += cv * wv.x; acc[b].y += cv * wv.y; acc[b].z += cv * wv.z; acc[b].w += cv * wv.w;
      }
    }
#pragma unroll
    for (int b = 0; b < 10; ++b) *(float4*)(red + (kg * 10 + b) * 64 + c4 * 4) = acc[b];
    __syncthreads();
    for (int e = tid; e < 640; e += NTHR) {
      int b = e >> 6, c = e & 63;
      float s_ = p.ada_b[l * 6144 + jc * 64 + c];
#pragma unroll 8
      for (int g = 0; g < 32; ++g) s_ += red[(g * 10 + b) * 64 + c];
      ((float*)(p.ws + OFF_MOD))[(l * 10 + b) * 6144 + jc * 64 + c] = s_;
    }
    __syncthreads();
    return;
  }
  item -= 192;
  if (item < 6080) {
    const float* src; u16* dst; int K, N, perm = 0, tl;
    if (item < 576) { src = p.even_w_in; dst = (u16*)(p.ws + OFF_WT_IN); K = 1024; N = 2304; tl = item; }
    else if (item < 832) { src = p.even_w_out; dst = (u16*)(p.ws + OFF_WT_OUT0); K = 1024; N = 1024; tl = item - 576; }
    else if (item < 2240) { src = p.ffn_w_up; dst = (u16*)(p.ws + OFF_WT_UP0); K = 1024; N = 5632; perm = 1; tl = item - 832; }
    else if (item < 3648) { src = p.ffn_w_up + (size_t)1024 * 5632; dst = (u16*)(p.ws + OFF_WT_UP1); K = 1024; N = 5632; perm = 1; tl = item - 2240; }
    else if (item < 4352) { src = p.ffn_w_down; dst = (u16*)(p.ws + OFF_WT_DN0); K = 2816; N = 1024; tl = item - 3648; }
    else if (item < 5056) { src = p.ffn_w_down + (size_t)2816 * 1024; dst = (u16*)(p.ws + OFF_WT_DN1); K = 2816; N = 1024; tl = item - 4352; }
    else if (item < 5824) { src = p.odd_w_qkv; dst = (u16*)(p.ws + OFF_WT_QKV); K = 1024; N = 3072; tl = item - 5056; }
    else { src = p.odd_w_out; dst = (u16*)(p.ws + OFF_WT_OUT1); K = 1024; N = 1024; tl = item - 5824; }
    const int ntn = N >> 6;
    const int k0 = (tl / ntn) << 6, n0 = (tl % ntn) << 6;
    float* T = (float*)lds;
    {
      const int kk = tid >> 4, n4 = tid & 15;
#pragma unroll
      for (int i = 0; i < 2; ++i) {
        const float4 v = *(const float4*)(src + (size_t)(k0 + kk + 32 * i) * N + n0 + 4 * n4);
        float* tr = T + (kk + 32 * i) * 65 + 4 * n4;
        tr[0] = v.x; tr[1] = v.y; tr[2] = v.z; tr[3] = v.w;
      }
    }
    __syncthreads();
    {
      const int nn = tid >> 3, k8 = tid & 7;
      const int n = n0 + nn;
      int row = n;
      if (perm) {
        if (n < DFF) row = ((n >> 7) << 8) + (n & 127);
        else { int n2 = n - DFF; row = ((n2 >> 7) << 8) + 128 + (n2 & 127); }
      }
      const float* tc = T + (8 * k8) * 65 + nn;
      u32x4 o4 = {pk_bf16(tc[0], tc[65]), pk_bf16(tc[130], tc[195]), pk_bf16(tc[260], tc[325]), pk_bf16(tc[390], tc[455])};
      *(u32x4*)(dst + (size_t)row * K + k0 + 8 * k8) = o4;
    }
    __syncthreads();
    return;
  }
  item -= 6080;
  {
#pragma unroll
    for (int i = 0; i < 8; ++i) {
      int e = item * 4096 + i * 512 + tid;
      int tab = e >> 19;
      int ee = e & 524287;
      int t = ee >> 5, j = ee & 31;
      float ang;
      if (tab == 0) ang = (float)t * INV1[j];
      else ang = (j < 16) ? (float)(t >> 6) * INV2[j] : (float)(t & 63) * INV2[j - 16];
      double rev = (double)ang * 0.15915494309189533577;
      double fr = rev - rint(rev);
      float f = (float)fr;
      f32x2 cs = {__builtin_amdgcn_cosf(f), __builtin_amdgcn_sinf(f)};
      ((f32x2*)(p.ws + (tab ? OFF_CS2 : OFF_CS1)))[ee] = cs;
    }
  }
}

DI void phase_ln(const Params& p, int layer, int sub, bool first, bool final_, const u16* M, int glayer, int goff) {
  const int tid = opaque_tid(), lane = tid & 63, w = tid >> 6;
  const float* gn = final_ ? p.final_g : (p.norm_g + (layer * 2 + sub) * 1024);
  const float* mod = (const float*)(p.ws + OFF_MOD);
  u16* H = (u16*)(p.ws + OFF_H);
  const int nw = gridDim.x * 8, gw = blockIdx.x * 8 + w;
  const int rows_per = (NTOK + nw - 1) / nw;
  const int r0 = gw * rows_per;
  const int r1 = (r0 + rows_per < NTOK) ? (r0 + rows_per) : NTOK;
  if (r0 >= r1) return;
  auto load_row = [&](int row, float4 (&v)[4], u32x2 (&mm)[4]) {
    const float* xr = first ? xin_row(p, row) : (p.out + (size_t)row * DM);
#pragma unroll
    for (int j = 0; j < 4; ++j) {
      const f32x4v t_ = __builtin_nontemporal_load((const f32x4v*)(xr + j * 256 + lane * 4));
      v[j] = (float4){t_.x, t_.y, t_.z, t_.w};
    }
    if (M) {
#pragma unroll
      for (int j = 0; j < 4; ++j) mm[j] = *(const u32x2*)(M + (size_t)row * DM + j * 256 + lane * 4);
    }
  };
  float4 pg[4], psh[4], pgm[4];
  int cur_bb = -1;
  float4 v[4], vn[4], vn2[4];
  u32x2 mm[4], mmn[4], mmn2[4];
#pragma unroll
  for (int j = 0; j < 4; ++j) {
    mm[j] = (u32x2){0u, 0u}; mmn[j] = (u32x2){0u, 0u}; mmn2[j] = (u32x2){0u, 0u};
    vn[j] = (float4){0.f, 0.f, 0.f, 0.f}; vn2[j] = (float4){0.f, 0.f, 0.f, 0.f};
  }
  load_row(r0, v, mm);
  if (r0 + 1 < r1) load_row(r0 + 1, vn, mmn);
  for (int row = r0; row < r1; ++row) {
    if (row + 2 < r1) load_row(row + 2, vn2, mmn2);
    int bb, tokbase, S;
    seq_of_token(row, bb, tokbase, S);
    if (bb != cur_bb) {
      cur_bb = bb;
      const float* mrow = mod + (layer * 10 + bb) * 6144 + sub * 3072;
      const float* grow = mod + (glayer * 10 + bb) * 6144 + goff;
#pragma unroll
      for (int j = 0; j < 4; ++j) {
        const int c = j * 256 + lane * 4;
        const float4 g = *(const float4*)(gn + c);
        if (final_) { pg[j] = g; psh[j] = (float4){0.f, 0.f, 0.f, 0.f}; }
        else {
          const float4 sh = *(const float4*)(mrow + c);
          const float4 sc = *(const float4*)(mrow + 1024 + c);
          pg[j] = (float4){g.x * (1.f + sc.x), g.y * (1.f + sc.y), g.z * (1.f + sc.z), g.w * (1.f + sc.w)};
          psh[j] = sh;
        }
        if (M) pgm[j] = *(const float4*)(grow + c);
      }
    }
    if (M) {
#pragma unroll
      for (int j = 0; j < 4; ++j) {
        const int c = j * 256 + lane * 4;
        v[j].x += pgm[j].x * __uint_as_float(mm[j].x << 16);
        v[j].y += pgm[j].y * __uint_as_float(mm[j].x & 0xffff0000u);
        v[j].z += pgm[j].z * __uint_as_float(mm[j].y << 16);
        v[j].w += pgm[j].w * __uint_as_float(mm[j].y & 0xffff0000u);
        if (!final_) {
          const f32x4v t_ = {v[j].x, v[j].y, v[j].z, v[j].w};
          __builtin_nontemporal_store(t_, (f32x4v*)(p.out + (size_t)row * DM + c));
        }
      }
    }
    float ss = 0.f;
#pragma unroll
    for (int j = 0; j < 4; ++j) ss += v[j].x * v[j].x + v[j].y * v[j].y + v[j].z * v[j].z + v[j].w * v[j].w;
#pragma unroll
    for (int o = 1; o < 64; o <<= 1) ss += __shfl_xor(ss, o);
    const float rstd = rsqrtf(ss * (1.f / 1024.f) + 1e-6f);
    if (final_) {
#pragma unroll
      for (int j = 0; j < 4; ++j) {
        float4 o4 = {v[j].x * rstd * pg[j].x, v[j].y * rstd * pg[j].y, v[j].z * rstd * pg[j].z, v[j].w * rstd * pg[j].w};
        const f32x4v t_ = {o4.x, o4.y, o4.z, o4.w};
        __builtin_nontemporal_store(t_, (f32x4v*)(p.out + (size_t)row * DM + j * 256 + lane * 4));
      }
    } else {
#pragma unroll
      for (int j = 0; j < 4; ++j) {
        const int c = j * 256 + lane * 4;
        const float a0 = v[j].x * rstd * pg[j].x + psh[j].x;
        const float a1 = v[j].y * rstd * pg[j].y + psh[j].y;
        const float a2 = v[j].z * rstd * pg[j].z + psh[j].z;
        const float a3 = v[j].w * rstd * pg[j].w + psh[j].w;
        u32x2 o2 = {pk_bf16(a0, a1), pk_bf16(a2, a3)};
        *(u32x2*)(H + (size_t)row * DM + c) = o2;
      }
    }
#pragma unroll
    for (int j = 0; j < 4; ++j) { v[j] = vn[j]; mm[j] = mmn[j]; vn[j] = vn2[j]; mmn[j] = mmn2[j]; }
  }
}

template <bool SWAP>
DI void gemm_mainloop(f32x16 (&acc)[4][2], const u16* __restrict__ A, int lda, int rlo, int rhi,
                      const u16* __restrict__ B, int ldb, int K, char* lds, const u16* zero_line) {
  const int tid = opaque_tid(), lane = tid & 63, w = tid >> 6;
  const int wm = w >> 2, wn = w & 3;
  const int h = lane >> 5, r = lane & 31;
  const int lr = tid >> 3, lc = tid & 7;
#pragma unroll
  for (int mi = 0; mi < 4; ++mi)
#pragma unroll
    for (int ni = 0; ni < 2; ++ni)
#pragma unroll
      for (int i = 0; i < 16; ++i) acc[mi][ni][i] = 0.f;
  const int gch = (lc ^ ((lr >> 1) & 7)) * 8;
  const u16* ap = A + (ptrdiff_t)lr * lda + gch;
  const u16* bp = B + (ptrdiff_t)lr * ldb + gch;
  const int nk = K >> 6;
  typedef __attribute__((address_space(3))) unsigned lds_u32;
  auto glds = [&](int kt, int st) {
    char* as_ = lds + st * 65536 + tid * 16;
#pragma unroll
    for (int i = 0; i < 4; ++i) {
      const int rr = lr + 64 * i;
      const u16* srca = (rr >= rlo && rr < rhi) ? (ap + (ptrdiff_t)(64 * i) * lda + kt * 64) : (zero_line + lc * 8);
      __builtin_amdgcn_global_load_lds((const unsigned*)srca, (lds_u32*)(as_ + i * 8192), 16, 0, 0);
      __builtin_amdgcn_global_load_lds((const unsigned*)(bp + (ptrdiff_t)(64 * i) * ldb + kt * 64), (lds_u32*)(as_ + 32768 + i * 8192), 16, 0, 0);
    }
  };
  const int sw = (r >> 1) & 7;
  const int arow_off = (wm * 128 + r) * 128;
  const int brow_off = 32768 + (wn * 64 + r) * 128;
  __syncthreads();
  glds(0, 0);
  asm volatile("s_waitcnt vmcnt(0)" ::: "memory");
  __syncthreads();
  bf16x8 fa[2][4], fb[2][2];
#pragma unroll
  for (int mi = 0; mi < 4; ++mi)
#pragma unroll
    for (int e = 0; e < 8; ++e) fa[1][mi][e] = 0;
#pragma unroll
  for (int ni = 0; ni < 2; ++ni)
#pragma unroll
    for (int e = 0; e < 8; ++e) fb[1][ni][e] = 0;
  auto ldfrag = [&](const char* st, int ks, int buf) {
    const int co = ((2 * ks + h) ^ sw) << 4;
#pragma unroll
    for (int mi = 0; mi < 4; ++mi) fa[buf][mi] = *(const bf16x8*)(st + arow_off + mi * 4096 + co);
#pragma unroll
    for (int ni = 0; ni < 2; ++ni) fb[buf][ni] = *(const bf16x8*)(st + brow_off + ni * 4096 + co);
  };
  auto mma = [&](int buf) {
#pragma unroll
    for (int mi = 0; mi < 4; ++mi)
#pragma unroll
      for (int ni = 0; ni < 2; ++ni)
        acc[mi][ni] = SWAP ? MFMA(fb[buf][ni], fa[buf][mi], acc[mi][ni]) : MFMA(fa[buf][mi], fb[buf][ni], acc[mi][ni]);
  };
  auto pat_rd = [&]() {
#pragma unroll
    for (int g = 0; g < 6; ++g) {
      __builtin_amdgcn_sched_group_barrier(0x100, 1, 0);
      __builtin_amdgcn_sched_group_barrier(0x008, 1, 0);
    }
    __builtin_amdgcn_sched_group_barrier(0x008, 2, 0);
  };
#pragma unroll 2
  for (int kt = 0; kt < nk; ++kt) {
    const char* st = lds + (kt & 1) * 65536;
    ldfrag(st, 0, 0);
    mma(1);
    pat_rd();
    if (kt + 1 < nk) glds(kt + 1, (kt + 1) & 1);
    ldfrag(st, 1, 1);
    mma(0);
    pat_rd();
    ldfrag(st, 2, 0);
    mma(1);
    pat_rd();
    ldfrag(st, 3, 1);
    mma(0);
    pat_rd();
    asm volatile("s_waitcnt vmcnt(0)" ::: "memory");
    __syncthreads();
  }
  mma(1);
}

DI void tile_mn(int t, int Mt, int Nt, int& m, int& n) {
  const int per = 8 * Nt;
  int g = t / per;
  int rem = t - g * per;
  int gs = Mt - g * 8;
  if (gs > 8) gs = 8;
  n = rem / gs;
  m = g * 8 + (rem - n * gs);
}

enum { EPI_INPROJ = 0, EPI_M = 1, EPI_UP = 2, EPI_QKV1 = 3 };

struct GemmArgs {
  const u16* A; int lda; const u16* Bt; int K; int Nt; int layer; u16* Mout;
};

template <int EPI>
DI void phase_gemm(const Params& p, const GemmArgs& ga, char* lds) {
  const int tid = opaque_tid(), lane = tid & 63, w = tid >> 6;
  const int wm = w >> 2, wn = w & 3;
  const int h = lane >> 5, r = lane & 31;
  const int Mt = (EPI == EPI_UP) ? 194 : 192;
  const int total = Mt * ga.Nt;
  for (int it = 0; it * (int)gridDim.x < total; ++it) {
    const int lt = logical_index(it);
    if (lt >= total) continue;
    int mt, nt;
    tile_mn(lt, Mt, ga.Nt, mt, nt);
    int bb, tokbase, S, pos0, rlo = 0, rhi = 256;
    if (EPI == EPI_UP) {
      bb = 0; tokbase = 0; S = NTOK;
      pos0 = 254 * mt - 1;
      rlo = (mt == 0) ? 1 : 0;
      rhi = NTOK - pos0; if (rhi > 256) rhi = 256;
    } else {
      seq_of_token(mt * 256, bb, tokbase, S);
      pos0 = mt * 256 - tokbase;
    }
    const u16* A = ga.A + (ptrdiff_t)(tokbase + pos0) * ga.lda;
    const u16* B = ga.Bt + (size_t)(nt * 256) * ga.K;
    f32x16 acc[4][2];
    bool swap;
    if (EPI == EPI_M) swap = true;
    else if (EPI == EPI_UP) swap = true;
    else if (EPI == EPI_QKV1) swap = (nt < 8);
    else swap = !(nt == 4 || nt == 5);
    if (swap) gemm_mainloop<true>(acc, A, ga.lda, rlo, rhi, B, ga.K, ga.K, lds, (const u16*)(p.ws + OFF_ZERO));
    else gemm_mainloop<false>(acc, A, ga.lda, rlo, rhi, B, ga.K, ga.K, lds, (const u16*)(p.ws + OFF_ZERO));

    const int n0w = nt * 256 + wn * 64;
    if (EPI == EPI_M) {
      u16* mo = ga.Mout + (size_t)(tokbase + pos0 + wm * 128 + r) * DM + n0w + 8 * h;
#pragma unroll
      for (int mi = 0; mi < 4; ++mi)
#pragma unroll
        for (int ni = 0; ni < 2; ++ni)
#pragma unroll
          for (int jp = 0; jp < 2; ++jp) {
            u32x2 X = {pk_bf16(acc[mi][ni][8 * jp], acc[mi][ni][8 * jp + 1]), pk_bf16(acc[mi][ni][8 * jp + 2], acc[mi][ni][8 * jp + 3])};
            u32x2 Y = {pk_bf16(acc[mi][ni][8 * jp + 4], acc[mi][ni][8 * jp + 5]), pk_bf16(acc[mi][ni][8 * jp + 6], acc[mi][ni][8 * jp + 7])};
            half_swap(X, Y);
            u32x4 v = {X.x, X.y, Y.x, Y.y};
            *(u32x4*)(mo + (size_t)(mi * 32) * DM + ni * 32 + 16 * jp) = v;
          }
    } else if (EPI == EPI_QKV1) {
      u16* QK = (u16*)(p.ws + OFF_BIG);
      u16* VT = (u16*)(p.ws + OFF_VT1);
      if (swap) {
        const float sc = (n0w < 1024) ? QK_SCALE_LOG2 : 1.f;
        u16* qo = QK + (size_t)(tokbase + pos0 + wm * 128 + r) * QK1_LD + n0w + 8 * h;
#pragma unroll
        for (int mi = 0; mi < 4; ++mi)
#pragma unroll
          for (int ni = 0; ni < 2; ++ni)
#pragma unroll
            for (int jp = 0; jp < 2; ++jp) {
              u32x2 X = {pk_bf16(acc[mi][ni][8 * jp] * sc, acc[mi][ni][8 * jp + 1] * sc), pk_bf16(acc[mi][ni][8 * jp + 2] * sc, acc[mi][ni][8 * jp + 3] * sc)};
              u32x2 Y = {pk_bf16(acc[mi][ni][8 * jp + 4] * sc, acc[mi][ni][8 * jp + 5] * sc), pk_bf16(acc[mi][ni][8 * jp + 6] * sc, acc[mi][ni][8 * jp + 7] * sc)};
              half_swap(X, Y);
              u32x4 v = {X.x, X.y, Y.x, Y.y};
              *(u32x4*)(qo + (size_t)(mi * 32) * QK1_LD + ni * 32 + 16 * jp) = v;
            }
      } else {
#pragma unroll
        for (int ni = 0; ni < 2; ++ni) {
          const int vrow = n0w - 2048 + ni * 32 + r;
          u16* vb = VT + (size_t)1024 * tokbase + (size_t)vrow * S;
#pragma unroll
          for (int mi = 0; mi < 4; ++mi)
#pragma unroll
            for (int jp = 0; jp < 2; ++jp) {
              const int pos = pos0 + wm * 128 + mi * 32 + 16 * jp + 8 * h;
              u32x2 X = {pk_bf16(acc[mi][ni][8 * jp], acc[mi][ni][8 * jp + 1]), pk_bf16(acc[mi][ni][8 * jp + 2], acc[mi][ni][8 * jp + 3])};
              u32x2 Y = {pk_bf16(acc[mi][ni][8 * jp + 4], acc[mi][ni][8 * jp + 5]), pk_bf16(acc[mi][ni][8 * jp + 6], acc[mi][ni][8 * jp + 7])};
              half_swap(X, Y);
              u32x4 v = {X.x, X.y, Y.x, Y.y};
              *(u32x4*)(vb + pos) = v;
            }
        }
      }
    } else if (EPI == EPI_INPROJ) {
      u16* QK = (u16*)(p.ws + OFF_BIG);
      u16* VT = (u16*)(p.ws + OFF_VT0);
      if (!swap) {
#pragma unroll
        for (int ni = 0; ni < 2; ++ni) {
          const int vrow = (n0w - 1024) + ni * 32 + r;
          u16* vb = VT + (size_t)640 * tokbase + (size_t)vrow * S;
#pragma unroll
          for (int mi = 0; mi < 4; ++mi)
#pragma unroll
            for (int jp = 0; jp < 2; ++jp) {
              const int pos = pos0 + wm * 128 + mi * 32 + 16 * jp + 8 * h;
              u32x2 X = {pk_bf16(acc[mi][ni][8 * jp], acc[mi][ni][8 * jp + 1]), pk_bf16(acc[mi][ni][8 * jp + 2], acc[mi][ni][8 * jp + 3])};
              u32x2 Y = {pk_bf16(acc[mi][ni][8 * jp + 4], acc[mi][ni][8 * jp + 5]), pk_bf16(acc[mi][ni][8 * jp + 6], acc[mi][ni][8 * jp + 7])};
              half_swap(X, Y);
              u32x4 v = {X.x, X.y, Y.x, Y.y};
              *(u32x4*)(vb + pos) = v;
            }
        }
      } else if (n0w >= 2176) {
#pragma unroll
        for (int ni = 0; ni < 2; ++ni)
#pragma unroll
          for (int i = 0; i < 16; ++i) {
            const int vrow = 512 + (n0w - 2176) + ni * 32 + 8 * (i >> 2) + 4 * h + (i & 3);
            u16* vb = VT + (size_t)640 * tokbase + (size_t)vrow * S + pos0 + wm * 128 + r;
#pragma unroll
            for (int mi = 0; mi < 4; ++mi) vb[mi * 32] = to_bf16(acc[mi][ni][i]);
          }
      } else {
        const bool nrm = (n0w >= 1536);
        int dcol;
        const float* gq = p.gqa_qk_g;
        float osc = 1.f;
        if (n0w < 1024) { dcol = n0w; if (n0w < 512) osc = QK_SCALE_LOG2; }
        else if (n0w < 2048) { dcol = 1024 + (n0w - 1536); osc = QK_SCALE_LOG2; }
        else { dcol = 1536 + (n0w - 2048); gq += 64; }
        const float* cs = (const float*)(p.ws + (nrm ? OFF_CS2 : OFF_CS1));
#pragma unroll
        for (int mi = 0; mi < 4; ++mi) {
          const int pos = pos0 + wm * 128 + mi * 32 + r;
          float rs = 1.f;
          if (nrm) {
            float ss = 0.f;
#pragma unroll
            for (int i = 0; i < 16; ++i) ss += acc[mi][0][i] * acc[mi][0][i] + acc[mi][1][i] * acc[mi][1][i];
            ss += __shfl_xor(ss, 32);
            rs = rsqrtf(ss * (1.f / 64.f) + 1e-6f);
          }
          u16* q = QK + (size_t)(tokbase + pos) * QK0_LD + dcol + 8 * h;
          const float* csr = cs + (size_t)pos * 64 + 8 * h;
#pragma unroll
          for (int jp = 0; jp < 2; ++jp) {
            u32x2 v1[2], v2[2];
#pragma unroll
            for (int jj = 0; jj < 2; ++jj) {
              const int j = 2 * jp + jj;
              const float4 ca = *(const float4*)(csr + 16 * j);
              const float4 cb = *(const float4*)(csr + 16 * j + 4);
              float x1[4], x2[4];
#pragma unroll
              for (int e = 0; e < 4; ++e) { x1[e] = acc[mi][0][4 * j + e]; x2[e] = acc[mi][1][4 * j + e]; }
              if (nrm) {
                const float4 ga_ = *(const float4*)(gq + 8 * j + 4 * h);
                const float4 gb_ = *(const float4*)(gq + 32 + 8 * j + 4 * h);
                x1[0] *= rs * ga_.x; x1[1] *= rs * ga_.y; x1[2] *= rs * ga_.z; x1[3] *= rs * ga_.w;
                x2[0] *= rs * gb_.x; x2[1] *= rs * gb_.y; x2[2] *= rs * gb_.z; x2[3] *= rs * gb_.w;
              }
              const float cc[4] = {ca.x, ca.z, cb.x, cb.z};
              const float sn[4] = {ca.y, ca.w, cb.y, cb.w};
              float y1[4], y2[4];
#pragma unroll
              for (int e = 0; e < 4; ++e) {
                y1[e] = (x1[e] * cc[e] - x2[e] * sn[e]) * osc;
                y2[e] = (x2[e] * cc[e] + x1[e] * sn[e]) * osc;
              }
              v1[jj] = (u32x2){pk_bf16(y1[0], y1[1]), pk_bf16(y1[2], y1[3])};
              v2[jj] = (u32x2){pk_bf16(y2[0], y2[1]), pk_bf16(y2[2], y2[3])};
            }
            half_swap(v1[0], v1[1]);
            half_swap(v2[0], v2[1]);
            u32x4 w1 = {v1[0].x, v1[0].y, v1[1].x, v1[1].y};
            u32x4 w2 = {v2[0].x, v2[0].y, v2[1].x, v2[1].y};
            *(u32x4*)(q + 16 * jp) = w1;
            *(u32x4*)(q + 32 + 16 * jp) = w2;
          }
        }
      }
    } else {
      __syncthreads();
      constexpr int RS = 520;
      {
        char* wbase = lds + (wm * 128 + r) * RS + (wn * 64 + 4 * h) * 2;
#pragma unroll
        for (int mi = 0; mi < 4; ++mi)
#pragma unroll
          for (int ni = 0; ni < 2; ++ni)
#pragma unroll
            for (int j = 0; j < 4; ++j) {
              u32x2 v = {pk_bf16(acc[mi][ni][4 * j], acc[mi][ni][4 * j + 1]), pk_bf16(acc[mi][ni][4 * j + 2], acc[mi][ni][4 * j + 3])};
              *(u32x2*)(wbase + mi * 32 * RS + (ni * 32 + 8 * j) * 2) = v;
            }
      }
      __syncthreads();
      {
        const int q4 = tid & 31, seg = tid >> 5;
        const int ch = nt * 128 + 4 * q4;
        const float* cw = p.ffn_conv_w + (size_t)ga.layer * 3 * 5632;
        const float* cb = p.ffn_conv_b + (size_t)ga.layer * 5632;
        float4 wg[3], wv[3];
#pragma unroll
        for (int t3 = 0; t3 < 3; ++t3) { wg[t3] = *(const float4*)(cw + t3 * 5632 + ch); wv[t3] = *(const float4*)(cw + t3 * 5632 + DFF + ch); }
        const float4 bg = *(const float4*)(cb + ch);
        const float4 bv = *(const float4*)(cb + DFF + ch);
        const char* gbase = lds + q4 * 8;
        const char* vbase = lds + 256 + q4 * 8;
        const int R0 = 1 + seg * 16;
        const int Rend = (R0 + 16 < 255) ? (R0 + 16) : 255;
        auto ld4 = [&](const char* b_, int R) -> float4 {
          const u32x2 u = *(const u32x2*)(b_ + R * RS);
          float4 f = {__uint_as_float(u.x << 16), __uint_as_float(u.x & 0xffff0000u), __uint_as_float(u.y << 16), __uint_as_float(u.y & 0xffff0000u)};
          return f;
        };
        float4 pg = ld4(gbase, R0 - 1), pvv = ld4(vbase, R0 - 1);
        float4 cg_ = ld4(gbase, R0), cv_ = ld4(vbase, R0);
        u16* Aout = (u16*)(p.ws + OFF_BIG) + (ptrdiff_t)(tokbase + pos0) * DFF + ch;
#pragma unroll 4
        for (int R = R0; R < Rend; ++R) {
          const float4 ng = ld4(gbase, R + 1), nv = ld4(vbase, R + 1);
          if (pos0 + R < S) {
            const int tflat = pos0 + R;
            const int ps = (tflat < NTOK_P) ? (tflat & (SP - 1)) : ((tflat - NTOK_P) & (SS - 1));
            const int Ss = (tflat < NTOK_P) ? SP : SS;
            const float mp = (ps == 0) ? 0.f : 1.f;
            const float mn = (ps == Ss - 1) ? 0.f : 1.f;
            float g[4], v[4];
            g[0] = mp * pg.x * wg[0].x + cg_.x * wg[1].x + mn * ng.x * wg[2].x + bg.x;
            g[1] = mp * pg.y * wg[0].y + cg_.y * wg[1].y + mn * ng.y * wg[2].y + bg.y;
            g[2] = mp * pg.z * wg[0].z + cg_.z * wg[1].z + mn * ng.z * wg[2].z + bg.z;
            g[3] = mp * pg.w * wg[0].w + cg_.w * wg[1].w + mn * ng.w * wg[2].w + bg.w;
            v[0] = mp * pvv.x * wv[0].x + cv_.x * wv[1].x + mn * nv.x * wv[2].x + bv.x;
            v[1] = mp * pvv.y * wv[0].y + cv_.y * wv[1].y + mn * nv.y * wv[2].y + bv.y;
            v[2] = mp * pvv.z * wv[0].z + cv_.z * wv[1].z + mn * nv.z * wv[2].z + bv.z;
            v[3] = mp * pvv.w * wv[0].w + cv_.w * wv[1].w + mn * nv.w * wv[2].w + bv.w;
            float a_[4];
#pragma unroll
            for (int e = 0; e < 4; ++e) a_[e] = g[e] * __builtin_amdgcn_rcpf(1.f + fexp2(-1.4426950408889634f * g[e])) * v[e];
            u32x2 ov = {pk_bf16(a_[0], a_[1]), pk_bf16(a_[2], a_[3])};
            *(u32x2*)(Aout + (ptrdiff_t)R * DFF) = ov;
          }
          pg = cg_; pvv = cv_; cg_ = ng; cv_ = nv;
        }
      }
    }
  }
}

constexpr int ATT_STAGE = 24576;
template <int DV, bool NA>
DI void flash_pass(f32x16 (&o)[DV / 32], const u16* __restrict__ Qp, const u16* __restrict__ Kb, int ldk,
                   const u16* __restrict__ Vt, int S, int tile0, int ntiles, char* lds, float cscale,
                   int wlo, int whi, const float* bias_lds, int r_w, int qc) {
  const int tid = opaque_tid(), lane = tid & 63;
  const int h = lane >> 5, r = lane & 31;
  bf16x8 q[4];
#pragma unroll
  for (int ks = 0; ks < 4; ++ks) q[ks] = *(const bf16x8*)(Qp + ks * 16 + h * 8);
#pragma unroll
  for (int mv = 0; mv < DV / 32; ++mv)
#pragma unroll
    for (int i = 0; i < 16; ++i) o[mv][i] = 0.f;
  float m_run = -INFINITY, l_run = 0.f;
  const int lr = tid >> 3, lc = tid & 7;
  const int wsw = lr * 128 + ((lc ^ ((lr >> 1) & 7)) << 4);
  u32x4 rk, rv[DV / 64];
  auto gload = [&](int ti) {
    const size_t key0 = (size_t)(tile0 + ti) * 64;
    rk = *(const u32x4*)(Kb + (key0 + lr) * ldk + lc * 8);
#pragma unroll
    for (int i = 0; i < DV / 64; ++i) rv[i] = *(const u32x4*)(Vt + (size_t)(lr + 64 * i) * S + key0 + lc * 8);
  };
  auto swrite = [&](int st) {
    char* ks_ = lds + st * ATT_STAGE;
    *(u32x4*)(ks_ + wsw) = rk;
#pragma unroll
    for (int i = 0; i < DV / 64; ++i) *(u32x4*)(ks_ + 8192 + i * 8192 + wsw) = rv[i];
  };
  const int pr = (r & 0x13) | ((r & 4) << 1) | ((r & 8) >> 1);
  const int ksw = (pr >> 1) & 7;
  const int vsw = (r >> 1) & 7;
  const int cs_ = NA ? min(max(qc - 8, 0), 48) : 0;
  __syncthreads();
  gload(0);
  swrite(0);
  if (ntiles > 1) gload(1);
  __syncthreads();
  for (int ti = 0; ti < ntiles; ++ti) {
    if (ti + 1 < ntiles) {
      swrite((ti + 1) & 1);
      if (ti + 2 < ntiles) gload(ti + 2);
    }
    const char* st = lds + (ti & 1) * ATT_STAGE;
    const bool active = !NA || ((tile0 + ti) >= wlo && (tile0 + ti) <= whi);
    if (active) {
      f32x16 s0, s1;
#pragma unroll
      for (int i = 0; i < 16; ++i) { s0[i] = 0.f; s1[i] = 0.f; }
      {
        bf16x8 ka[4], kb_[4];
#pragma unroll
        for (int ks = 0; ks < 4; ++ks) {
          const int co = ((2 * ks + h) ^ ksw) << 4;
          ka[ks] = *(const bf16x8*)(st + pr * 128 + co);
          kb_[ks] = *(const bf16x8*)(st + (32 + pr) * 128 + co);
        }
        asm volatile("" ::: "memory");
#pragma unroll
        for (int ks = 0; ks < 4; ++ks) {
          s0 = MFMA(ka[ks], q[ks], s0);
          s1 = MFMA(kb_[ks], q[ks], s1);
        }
      }
      bf16x8 vf0[2][DV / 32];
#pragma unroll
      for (int c2 = 0; c2 < 2; ++c2) {
        const int co = ((2 * c2 + h) ^ vsw) << 4;
#pragma unroll
        for (int mv = 0; mv < DV / 32; ++mv) vf0[c2][mv] = *(const bf16x8*)(st + 8192 + (mv * 32 + r) * 128 + co);
      }
      asm volatile("" ::: "memory");
      float t[32];
#pragma unroll
      for (int i = 0; i < 16; ++i) { t[i] = s0[i]; t[16 + i] = s1[i]; }
      if (NA) {
        const int kr = tile0 + ti;
        const int brow = (kr - r_w + 7) * 31;
#pragma unroll
        for (int e = 0; e < 32; ++e) {
          const int i = e & 15, j = i >> 2;
          const int kc = (e >> 4) * 32 + 16 * (j >> 1) + 8 * h + 4 * (j & 1) + (i & 3);
          const bool valid = (kc >= cs_) && (kc < cs_ + 16);
          const int bi = valid ? (brow + kc - qc + 15) : 0;
          const float bv = bias_lds[bi];
          t[e] = valid ? (t[e] + bv) : -INFINITY;
        }
      }
      float mx = t[0];
#pragma unroll
      for (int e = 1; e < 32; ++e) mx = fmaxf(mx, t[e]);
      mx = fmaxf(mx, __shfl_xor(mx, 32));
      if (__builtin_amdgcn_ballot_w64(mx > m_run + 8.f) != 0ull) {
        const float m_new = fmaxf(m_run, mx);
        const float alpha = fexp2(m_run - m_new);
        l_run *= alpha;
        m_run = m_new;
#pragma unroll
        for (int mv = 0; mv < DV / 32; ++mv)
#pragma unroll
          for (int i = 0; i < 16; ++i) o[mv][i] *= alpha;
      }
      float ls = 0.f;
#pragma unroll
      for (int e = 0; e < 32; ++e) { t[e] = fexp2(t[e] - m_run); ls += t[e]; }
      l_run += ls;
      bf16x8 pf[2][2];
#pragma unroll
      for (int kb = 0; kb < 2; ++kb)
#pragma unroll
        for (int c2 = 0; c2 < 2; ++c2) {
          const int e0 = kb * 16 + c2 * 8;
          u32x4 pw = {pk_bf16(t[e0], t[e0 + 1]), pk_bf16(t[e0 + 2], t[e0 + 3]), pk_bf16(t[e0 + 4], t[e0 + 5]), pk_bf16(t[e0 + 6], t[e0 + 7])};
          pf[kb][c2] = __builtin_bit_cast(bf16x8, pw);
        }
      bf16x8 vf1[2][DV / 32];
#pragma unroll
      for (int c2 = 0; c2 < 2; ++c2) {
        const int co = ((4 + 2 * c2 + h) ^ vsw) << 4;
#pragma unroll
        for (int mv = 0; mv < DV / 32; ++mv) vf1[c2][mv] = *(const bf16x8*)(st + 8192 + (mv * 32 + r) * 128 + co);
      }
      asm volatile("" ::: "memory");
#pragma unroll
      for (int c2 = 0; c2 < 2; ++c2)
#pragma unroll
        for (int mv = 0; mv < DV / 32; ++mv) o[mv] = MFMA(vf0[c2][mv], pf[0][c2], o[mv]);
#pragma unroll
      for (int c2 = 0; c2 < 2; ++c2)
#pragma unroll
        for (int mv = 0; mv < DV / 32; ++mv) o[mv] = MFMA(vf1[c2][mv], pf[1][c2], o[mv]);
    }
    __syncthreads();
  }
  const float lt = l_run + __shfl_xor(l_run, 32);
  const float inv = 1.f / lt;
#pragma unroll
  for (int mv = 0; mv < DV / 32; ++mv)
#pragma unroll
    for (int i = 0; i < 16; ++i) o[mv][i] *= inv;
}


DI void flash_pass_q2(f32x16 (&o)[2][2], const u16* __restrict__ Qp0, const u16* __restrict__ Qp1,
                      const u16* __restrict__ Kb, int ldk, const u16* __restrict__ Vt, int S, int ntiles, char* lds) {
  const int tid = opaque_tid(), lane = tid & 63;
  const int h = lane >> 5, r = lane & 31;
  bf16x8 q[2][4];
#pragma unroll
  for (int ks = 0; ks < 4; ++ks) {
    q[0][ks] = *(const bf16x8*)(Qp0 + ks * 16 + h * 8);
    q[1][ks] = *(const bf16x8*)(Qp1 + ks * 16 + h * 8);
  }
#pragma unroll
  for (int hq = 0; hq < 2; ++hq)
#pragma unroll
    for (int mv = 0; mv < 2; ++mv)
#pragma unroll
      for (int i = 0; i < 16; ++i) o[hq][mv][i] = 0.f;
  float m_run[2] = {-INFINITY, -INFINITY}, l_run[2] = {0.f, 0.f};
  const int lr = tid >> 3, lc = tid & 7;
  const int wsw = lr * 128 + ((lc ^ ((lr >> 1) & 7)) << 4);
  u32x4 rk, rv;
  auto gload = [&](int ti) {
    const size_t key0 = (size_t)ti * 64;
    rk = *(const u32x4*)(Kb + (key0 + lr) * ldk + lc * 8);
    rv = *(const u32x4*)(Vt + (size_t)lr * S + key0 + lc * 8);
  };
  auto swrite = [&](int st) {
    char* ks_ = lds + st * ATT_STAGE;
    *(u32x4*)(ks_ + wsw) = rk;
    *(u32x4*)(ks_ + 8192 + wsw) = rv;
  };
  const int pr = (r & 0x13) | ((r & 4) << 1) | ((r & 8) >> 1);
  const int ksw = (pr >> 1) & 7;
  const int vsw = (r >> 1) & 7;
  __syncthreads();
  gload(0);
  swrite(0);
  if (ntiles > 1) gload(1);
  __syncthreads();
  for (int ti = 0; ti < ntiles; ++ti) {
    if (ti + 1 < ntiles) {
      swrite((ti + 1) & 1);
      if (ti + 2 < ntiles) gload(ti + 2);
    }
    const char* st = lds + (ti & 1) * ATT_STAGE;
    f32x16 s[2][2];
#pragma unroll
    for (int hq = 0; hq < 2; ++hq)
#pragma unroll
      for (int kb = 0; kb < 2; ++kb)
#pragma unroll
        for (int i = 0; i < 16; ++i) s[hq][kb][i] = 0.f;
    {
      bf16x8 ka[4], kb_[4];
#pragma unroll
      for (int ks = 0; ks < 4; ++ks) {
        const int co = ((2 * ks + h) ^ ksw) << 4;
        ka[ks] = *(const bf16x8*)(st + pr * 128 + co);
        kb_[ks] = *(const bf16x8*)(st + (32 + pr) * 128 + co);
      }
      asm volatile("" ::: "memory");
#pragma unroll
      for (int ks = 0; ks < 4; ++ks) {
        s[0][0] = MFMA(ka[ks], q[0][ks], s[0][0]);
        s[0][1] = MFMA(kb_[ks], q[0][ks], s[0][1]);
        s[1][0] = MFMA(ka[ks], q[1][ks], s[1][0]);
        s[1][1] = MFMA(kb_[ks], q[1][ks], s[1][1]);
      }
    }
    bf16x8 pf[2][2][2];
#pragma unroll
    for (int hq = 0; hq < 2; ++hq) {
      float t[32];
#pragma unroll
      for (int i = 0; i < 16; ++i) { t[i] = s[hq][0][i]; t[16 + i] = s[hq][1][i]; }
      float mx = t[0];
#pragma unroll
      for (int e = 1; e < 32; ++e) mx = fmaxf(mx, t[e]);
      mx = fmaxf(mx, __shfl_xor(mx, 32));
      if (__builtin_amdgcn_ballot_w64(mx > m_run[hq] + 8.f) != 0ull) {
        const float m_new = fmaxf(m_run[hq], mx);
        const float alpha = fexp2(m_run[hq] - m_new);
        l_run[hq] *= alpha;
        m_run[hq] = m_new;
#pragma unroll
        for (int mv = 0; mv < 2; ++mv)
#pragma unroll
          for (int i = 0; i < 16; ++i) o[hq][mv][i] *= alpha;
      }
      float ls = 0.f;
#pragma unroll
      for (int e = 0; e < 32; ++e) { t[e] = fexp2(t[e] - m_run[hq]); ls += t[e]; }
      l_run[hq] += ls;
#pragma unroll
      for (int kb = 0; kb < 2; ++kb)
#pragma unroll
        for (int c2 = 0; c2 < 2; ++c2) {
          const int e0 = kb * 16 + c2 * 8;
          u32x4 pw = {pk_bf16(t[e0], t[e0 + 1]), pk_bf16(t[e0 + 2], t[e0 + 3]), pk_bf16(t[e0 + 4], t[e0 + 5]), pk_bf16(t[e0 + 6], t[e0 + 7])};
          pf[hq][kb][c2] = __builtin_bit_cast(bf16x8, pw);
        }
    }
    bf16x8 vf[2][2][2];
#pragma unroll
    for (int kb = 0; kb < 2; ++kb)
#pragma unroll
      for (int c2 = 0; c2 < 2; ++c2) {
        const int co = ((4 * kb + 2 * c2 + h) ^ vsw) << 4;
#pragma unroll
        for (int mv = 0; mv < 2; ++mv) vf[kb][c2][mv] = *(const bf16x8*)(st + 8192 + (mv * 32 + r) * 128 + co);
      }
    asm volatile("" ::: "memory");
#pragma unroll
    for (int kb = 0; kb < 2; ++kb)
#pragma unroll
      for (int c2 = 0; c2 < 2; ++c2)
#pragma unroll
        for (int mv = 0; mv < 2; ++mv) {
          o[0][mv] = MFMA(vf[kb][c2][mv], pf[0][kb][c2], o[0][mv]);
          o[1][mv] = MFMA(vf[kb][c2][mv], pf[1][kb][c2], o[1][mv]);
        }
    __syncthreads();
  }
#pragma unroll
  for (int hq = 0; hq < 2; ++hq) {
    const float lt = l_run[hq] + __shfl_xor(l_run[hq], 32);
    const float inv = 1.f / lt;
#pragma unroll
    for (int mv = 0; mv < 2; ++mv)
#pragma unroll
      for (int i = 0; i < 16; ++i) o[hq][mv][i] *= inv;
  }
}

DI void flash_pass_na(f32x16 (&o)[2], const u16* __restrict__ Qp, const u16* __restrict__ Kb, int ldk,
                      const u16* __restrict__ Vt, int S, int tile0, int ntiles, char* lds, int wlo, int whi,
                      const float* bias_lds, int qrow, int rs_q, int qcol, int cs0) {
  const int tid = opaque_tid(), lane = tid & 63;
  const int h = lane >> 5, r = lane & 31;
  bf16x8 q[4];
#pragma unroll
  for (int ks = 0; ks < 4; ++ks) q[ks] = *(const bf16x8*)(Qp + ks * 16 + h * 8);
#pragma unroll
  for (int mv = 0; mv < 2; ++mv)
#pragma unroll
    for (int i = 0; i < 16; ++i) o[mv][i] = 0.f;
  float m_run = -1e30f, l_run = 0.f;
  const int lr = tid >> 3, lc = tid & 7;
  const int wsw = lr * 128 + ((lc ^ ((lr >> 1) & 7)) << 4);
  u32x4 rk, rv;
  auto gload = [&](int ti) {
    const size_t key0 = (size_t)(tile0 + ti) * 64;
    rk = *(const u32x4*)(Kb + (key0 + lr) * ldk + lc * 8);
    rv = *(const u32x4*)(Vt + (size_t)lr * S + key0 + lc * 8);
  };
  auto swrite = [&](int st) {
    char* ks_ = lds + st * ATT_STAGE;
    *(u32x4*)(ks_ + wsw) = rk;
    *(u32x4*)(ks_ + 8192 + wsw) = rv;
  };
  const int pr = (r & 0x13) | ((r & 4) << 1) | ((r & 8) >> 1);
  const int krow = cs0 + pr;
  const int ksw = (krow >> 1) & 7;
  const int vsw = (r >> 1) & 7;
  const int vch0 = cs0 >> 3;
  const int csq = min(max(qcol - 8, 0), 48);
  bool navalid[16];
#pragma unroll
  for (int i = 0; i < 16; ++i) {
    const int j = i >> 2;
    const int kc = cs0 + 16 * (j >> 1) + 8 * h + 4 * (j & 1) + (i & 3);
    navalid[i] = (unsigned)(kc - csq) < 16u;
  }
  const int dcb = cs0 + 8 * h - qcol + 15;
  __syncthreads();
  gload(0);
  swrite(0);
  if (ntiles > 1) gload(1);
  __syncthreads();
  for (int ti = 0; ti < ntiles; ++ti) {
    if (ti + 1 < ntiles) {
      swrite((ti + 1) & 1);
      if (ti + 2 < ntiles) gload(ti + 2);
    }
    const char* st = lds + (ti & 1) * ATT_STAGE;
    const int kr = tile0 + ti;
    if (kr >= wlo && kr <= whi) {
      f32x16 s0;
#pragma unroll
      for (int i = 0; i < 16; ++i) s0[i] = 0.f;
      {
        bf16x8 ka[4];
#pragma unroll
        for (int ks = 0; ks < 4; ++ks) ka[ks] = *(const bf16x8*)(st + krow * 128 + (((2 * ks + h) ^ ksw) << 4));
        asm volatile("" ::: "memory");
#pragma unroll
        for (int ks = 0; ks < 4; ++ks) s0 = MFMA(ka[ks], q[ks], s0);
      }
      bf16x8 vf[2][2];
#pragma unroll
      for (int c2 = 0; c2 < 2; ++c2) {
        const int co = ((vch0 + 2 * c2 + h) ^ vsw) << 4;
#pragma unroll
        for (int mv = 0; mv < 2; ++mv) vf[c2][mv] = *(const bf16x8*)(st + 8192 + (mv * 32 + r) * 128 + co);
      }
      asm volatile("" ::: "memory");
      const bool rowok = (kr >= rs_q) && (kr <= rs_q + 7);
      const int bidx = rowok ? ((kr - qrow + 7) * 31 + dcb) : 64;
      float t[16];
#pragma unroll
      for (int i = 0; i < 16; ++i) {
        const int j = i >> 2;
        const int kco = 16 * (j >> 1) + 4 * (j & 1) + (i & 3);
        const bool ok = navalid[i] && rowok;
        const float bv = bias_lds[ok ? (bidx + kco) : 0];
        t[i] = ok ? (s0[i] + bv) : -INFINITY;
      }
      float mx = t[0];
#pragma unroll
      for (int e = 1; e < 16; ++e) mx = fmaxf(mx, t[e]);
      mx = fmaxf(mx, __shfl_xor(mx, 32));
      if (__builtin_amdgcn_ballot_w64(mx > m_run + 8.f) != 0ull) {
        const float m_new = fmaxf(m_run, mx);
        const float alpha = fexp2(m_run - m_new);
        l_run *= alpha;
        m_run = m_new;
#pragma unroll
        for (int mv = 0; mv < 2; ++mv)
#pragma unroll
          for (int i = 0; i < 16; ++i) o[mv][i] *= alpha;
      }
      float ls = 0.f;
#pragma unroll
      for (int e = 0; e < 16; ++e) { t[e] = fexp2(t[e] - m_run); ls += t[e]; }
      l_run += ls;
#pragma unroll
      for (int c2 = 0; c2 < 2; ++c2) {
        const int e0 = c2 * 8;
        u32x4 pw = {pk_bf16(t[e0], t[e0 + 1]), pk_bf16(t[e0 + 2], t[e0 + 3]), pk_bf16(t[e0 + 4], t[e0 + 5]), pk_bf16(t[e0 + 6], t[e0 + 7])};
        const bf16x8 pf = __builtin_bit_cast(bf16x8, pw);
#pragma unroll
        for (int mv = 0; mv < 2; ++mv) o[mv] = MFMA(vf[c2][mv], pf, o[mv]);
      }
    }
    __syncthreads();
  }
  const float lt = l_run + __shfl_xor(l_run, 32);
  const float inv = 1.f / lt;
#pragma unroll
  for (int mv = 0; mv < 2; ++mv)
#pragma unroll
    for (int i = 0; i < 16; ++i) o[mv][i] *= inv;
}

DI void phase_attn0(const Params& p, char* lds) {
  const int tid = opaque_tid(), lane = tid & 63, w = tid >> 6;
  const int h = lane >> 5, r = lane & 31;
  const u16* QK = (const u16*)(p.ws + OFF_BIG);
  const u16* VT = (const u16*)(p.ws + OFF_VT0);
  u16* O = (u16*)(p.ws + OFF_H);
  float* stash = (float*)(p.ws + OFF_STASH) + (((size_t)blockIdx.x * 8 + w) * 64 + lane) * 64;
  float lam;
  {
    const float* lf = p.diff_lambda;
    float a = lf[lane] * lf[64 + lane];
    float b = lf[128 + lane] * lf[192 + lane];
#pragma unroll
    for (int o_ = 1; o_ < 64; o_ <<= 1) { a += __shfl_xor(a, o_); b += __shfl_xor(b, o_); }
    lam = __expf(a) - __expf(b) + 0.2f;
  }
  const int total = 1536;
  const int G = gridDim.x;
  const bool dyn = ((G & 7) == 0);
  unsigned* qhead = (unsigned*)(p.ws + OFF_BAR + 256 * (1 + (blockIdx.x & 7)));
  volatile int* qslot = (volatile int*)(lds + 2 * ATT_STAGE + 4096);
  for (int it0 = 0;; ++it0) {
    int lt;
    if (dyn) {
      __syncthreads();
      if (tid == 0) *qslot = (int)__hip_atomic_fetch_add(qhead, 1u, __ATOMIC_RELAXED, __HIP_MEMORY_SCOPE_AGENT);
      __syncthreads();
      const int k = *qslot;
      const int per = G >> 3;
      const int it = k / per;
      if (it * G >= total) break;
      lt = it * G + (blockIdx.x & 7) * per + (k - it * per);
    } else {
      if (it0 * G >= total) break;
      lt = it0 * G + blockIdx.x;
    }
    if (lt >= total) continue;
    int cls, bb, head, qb, S, tokbase;
    if (lt < 512) { cls = 0; bb = lt >> 8; head = (lt >> 6) & 3; qb = lt & 63; }
    else if (lt < 1024) { int u = lt - 512; cls = 1; bb = u >> 8; head = (u >> 6) & 3; qb = u & 63; }
    else if (lt < 1280) { int u = lt - 1024; cls = 0; bb = 2 + (u >> 5); head = (u >> 3) & 3; qb = u & 7; }
    else { int u = lt - 1280; cls = 1; bb = 2 + (u >> 5); head = (u >> 3) & 3; qb = u & 7; }
    if (bb < 2) { S = SP; tokbase = bb * SP; } else { S = SS; tokbase = NTOK_P + (bb - 2) * SS; }
    const int tq = tokbase + qb * 256 + w * 32 + r;
    const u16* Kseq = QK + (size_t)tokbase * QK0_LD;
    const u16* Vseq = VT + (size_t)640 * tokbase;
    if (cls == 0) {
      f32x16 o[4];
#pragma unroll 1
      for (int comp = 0; comp < 2; ++comp) {
        const int hc = head * 2 + comp;
        flash_pass<128, false>(o, QK + (size_t)tq * QK0_LD + hc * 64, Kseq + 512 + hc * 64, QK0_LD,
                               Vseq + (size_t)(head * 128) * S, S, 0, S >> 6, lds, QK_SCALE_LOG2, 0, 0, nullptr, 0, 0);
        if (comp == 0) {
#pragma unroll
          for (int mv = 0; mv < 4; ++mv) {
#pragma unroll
            for (int i = 0; i < 4; ++i) {
              float4 v4 = {o[mv][4 * i], o[mv][4 * i + 1], o[mv][4 * i + 2], o[mv][4 * i + 3]};
              *(float4*)(stash + mv * 16 + i * 4) = v4;
            }
            asm volatile("" ::: "memory");
          }
        }
      }
      float ss = 0.f;
#pragma unroll
      for (int mv = 0; mv < 4; ++mv) {
#pragma unroll
        for (int i = 0; i < 4; ++i) {
          const float4 s4 = *(const float4*)(stash + mv * 16 + i * 4);
          float v;
          v = s4.x - lam * o[mv][4 * i]; o[mv][4 * i] = v; ss += v * v;
          v = s4.y - lam * o[mv][4 * i + 1]; o[mv][4 * i + 1] = v; ss += v * v;
          v = s4.z - lam * o[mv][4 * i + 2]; o[mv][4 * i + 2] = v; ss += v * v;
          v = s4.w - lam * o[mv][4 * i + 3]; o[mv][4 * i + 3] = v; ss += v * v;
        }
        asm volatile("" ::: "memory");
      }
      ss += __shfl_xor(ss, 32);
      const float rs = rsqrtf(ss * (1.f / 128.f) + 1e-5f) * 0.8f;
      u16* orow = O + (size_t)tq * DM + head * 128;
#pragma unroll
      for (int mv = 0; mv < 4; ++mv) {
#pragma unroll
        for (int jp = 0; jp < 2; ++jp) {
          u32x2 XY[2];
#pragma unroll
          for (int jj = 0; jj < 2; ++jj) {
            const int j = 2 * jp + jj;
            const float4 g = *(const float4*)(p.diff_subln_g + mv * 32 + 8 * j + 4 * h);
            XY[jj] = (u32x2){pk_bf16(o[mv][4 * j] * rs * g.x, o[mv][4 * j + 1] * rs * g.y),
                             pk_bf16(o[mv][4 * j + 2] * rs * g.z, o[mv][4 * j + 3] * rs * g.w)};
          }
          half_swap(XY[0], XY[1]);
          u32x4 v = {XY[0].x, XY[0].y, XY[1].x, XY[1].y};
          *(u32x4*)(orow + mv * 32 + 16 * jp + 8 * h) = v;
        }
        asm volatile("" ::: "memory");
      }
    } else {
      f32x16 o[2][2];
      const int kvh = head >> 1;
      const u16* qrow = QK + (size_t)tq * QK0_LD + 1024 + (2 * head) * 64;
      flash_pass_q2(o, qrow, qrow + 64, Kseq + 1536 + kvh * 64, QK0_LD, Vseq + (size_t)(512 + kvh * 64) * S, S, S >> 6, lds);
#pragma unroll
      for (int hq = 0; hq < 2; ++hq) {
        u16* orow = O + (size_t)tq * DM + 512 + (2 * head + hq) * 64;
#pragma unroll
        for (int mv = 0; mv < 2; ++mv)
#pragma unroll
          for (int jp = 0; jp < 2; ++jp) {
            u32x2 X = {pk_bf16(o[hq][mv][8 * jp], o[hq][mv][8 * jp + 1]), pk_bf16(o[hq][mv][8 * jp + 2], o[hq][mv][8 * jp + 3])};
            u32x2 Y = {pk_bf16(o[hq][mv][8 * jp + 4], o[hq][mv][8 * jp + 5]), pk_bf16(o[hq][mv][8 * jp + 6], o[hq][mv][8 * jp + 7])};
            half_swap(X, Y);
            u32x4 v = {X.x, X.y, Y.x, Y.y};
            *(u32x4*)(orow + mv * 32 + 16 * jp + 8 * h) = v;
          }
      }
    }
  }
}

DI void phase_na(const Params& p, char* lds) {
  const int tid = opaque_tid(), lane = tid & 63, w = tid >> 6;
  const int h = lane >> 5, r = lane & 31;
  const u16* QK = (const u16*)(p.ws + OFF_BIG);
  const u16* VT = (const u16*)(p.ws + OFF_VT1);
  u16* O = (u16*)(p.ws + OFF_H);
  float* bias = (float*)(lds + 2 * ATT_STAGE);
  const int total = 3072;
  for (int it = 0; it * (int)gridDim.x < total; ++it) {
    const int lt = logical_index(it);
    if (lt >= total) continue;
    int bb, head, r4, S, tokbase, rows;
    if (lt < 2048) { bb = lt >> 10; head = (lt >> 6) & 15; r4 = lt & 63; S = SP; tokbase = bb * SP; rows = 256; }
    else { int u = lt - 2048; bb = 2 + (u >> 7); head = (u >> 3) & 15; r4 = u & 7; S = SS; tokbase = NTOK_P + (bb - 2) * SS; rows = 32; }
    __syncthreads();
    for (int e = tid; e < 465; e += NTHR) bias[e] = p.odd_rpb[head * 465 + e] * 1.4426950408889634f;
    const int rfirst = r4 * 4, rlast = r4 * 4 + 3;
    const int rs_first = min(max(rfirst - 4, 0), rows - 8);
    const int rs_last = min(max(rlast - 4, 0), rows - 8);
    const int ntiles = rs_last + 8 - rs_first;
    const int rp0 = rfirst + 2 * (w >> 2);
    const int cq = w & 3;
    const int qrow = rp0 + (r >> 4);
    const int qcol = 16 * cq + (r & 15);
    const int rs_q = min(max(qrow - 4, 0), rows - 8);
    const int wlo = min(max(rp0 - 4, 0), rows - 8);
    const int whi = min(max(rp0 + 1 - 4, 0), rows - 8) + 7;
    const int cs0 = min(max(16 * cq - 8, 0), 32);
    const int tq = tokbase + qrow * 64 + qcol;
    f32x16 o[2];
    flash_pass_na(o, QK + (size_t)tq * QK1_LD + head * 64, QK + (size_t)tokbase * QK1_LD + 1024 + head * 64, QK1_LD,
                  VT + (size_t)1024 * tokbase + (size_t)(head * 64) * S, S, rs_first, ntiles, lds,
                  wlo, whi, bias, qrow, rs_q, qcol, cs0);
    u16* orow = O + (size_t)tq * DM + head * 64;
#pragma unroll
    for (int mv = 0; mv < 2; ++mv)
#pragma unroll
      for (int jp = 0; jp < 2; ++jp) {
        u32x2 X = {pk_bf16(o[mv][8 * jp], o[mv][8 * jp + 1]), pk_bf16(o[mv][8 * jp + 2], o[mv][8 * jp + 3])};
        u32x2 Y = {pk_bf16(o[mv][8 * jp + 4], o[mv][8 * jp + 5]), pk_bf16(o[mv][8 * jp + 6], o[mv][8 * jp + 7])};
        half_swap(X, Y);
        u32x4 v = {X.x, X.y, Y.x, Y.y};
        *(u32x4*)(orow + mv * 32 + 16 * jp + 8 * h) = v;
      }
  }
}

DI void grid_barrier(unsigned* ctr, unsigned target) {
  asm volatile("s_waitcnt vmcnt(0)" ::: "memory");
  __syncthreads();
  if (threadIdx.x == 0) {
    __builtin_amdgcn_fence(__ATOMIC_RELEASE, "agent");
    asm volatile("s_waitcnt vmcnt(0)" ::: "memory");
    __hip_atomic_fetch_add(ctr, 1u, __ATOMIC_RELAXED, __HIP_MEMORY_SCOPE_AGENT);
    while (__hip_atomic_load(ctr, __ATOMIC_RELAXED, __HIP_MEMORY_SCOPE_AGENT) < target) __builtin_amdgcn_s_sleep(1);
    __builtin_amdgcn_fence(__ATOMIC_ACQUIRE, "agent");
    asm volatile("s_waitcnt vmcnt(0)" ::: "memory");
  }
  __syncthreads();
}

__global__ void __launch_bounds__(NTHR) mega(Params p, int ph0, int ph1) {
  __shared__ __attribute__((aligned(16))) char lds[LDS_BYTES];
  unsigned* bar = (unsigned*)(p.ws + OFF_BAR);
  if (ph0 == 0 && blockIdx.x == 0 && threadIdx.x < 9)
    __hip_atomic_store((unsigned*)(p.ws + OFF_BAR + 256 * threadIdx.x), 0u, __ATOMIC_RELAXED, __HIP_MEMORY_SCOPE_AGENT);
  if (ph0 == 0 && blockIdx.x == 0 && threadIdx.x >= 64 && threadIdx.x < 128) ((unsigned*)(p.ws + OFF_ZERO))[threadIdx.x - 64] = 0u;
  unsigned nbar = 0;
  for (int ph = ph0; ph < ph1; ++ph) {
    if (ph > ph0) {
      if (ph == ph0 + 1) cg::this_grid().sync();
      else { ++nbar; grid_barrier(bar, nbar * gridDim.x); }
    }
    const u16* H = (const u16*)(p.ws + OFF_H);
    u16* Hm = (u16*)(p.ws + OFF_H);
    const u16* Abuf = (const u16*)(p.ws + OFF_BIG);
    u16* Bm = (u16*)(p.ws + OFF_BIG);
    switch (ph) {
      case 0:
        for (int item = blockIdx.x; item < 6528; item += gridDim.x) phase0_item(p, item, lds);
        break;
      case 1: phase_ln(p, 0, 0, true, false, nullptr, 0, 0); break;
      case 2: { GemmArgs ga{H, DM, (const u16*)(p.ws + OFF_WT_IN), 1024, 9, 0, nullptr}; phase_gemm<EPI_INPROJ>(p, ga, lds); } break;
      case 3: phase_attn0(p, lds); break;
      case 5: phase_ln(p, 0, 1, true, false, Abuf, 0, 2048); break;
      case 6: { GemmArgs ga{H, DM, (const u16*)(p.ws + OFF_WT_UP0), 1024, 22, 0, nullptr}; phase_gemm<EPI_UP>(p, ga, lds); } break;
      case 8: phase_ln(p, 1, 0, false, false, H, 0, 5120); break;
      case 9: { GemmArgs ga{H, DM, (const u16*)(p.ws + OFF_WT_QKV), 1024, 12, 1, nullptr}; phase_gemm<EPI_QKV1>(p, ga, lds); } break;
      case 10: phase_na(p, lds); break;
      case 12: phase_ln(p, 1, 1, false, false, Abuf, 1, 2048); break;
      case 13: { GemmArgs ga{H, DM, (const u16*)(p.ws + OFF_WT_UP1), 1024, 22, 1, nullptr}; phase_gemm<EPI_UP>(p, ga, lds); } break;
      case 15: phase_ln(p, 0, 0, false, true, H, 1, 5120); break;
      case 4: case 7: case 11: case 14: {
        GemmArgs ga;
        if (ph == 4) ga = GemmArgs{H, DM, (const u16*)(p.ws + OFF_WT_OUT0), 1024, 4, 0, Bm};
        else if (ph == 7) ga = GemmArgs{Abuf, DFF, (const u16*)(p.ws + OFF_WT_DN0), 2816, 4, 0, Hm};
        else if (ph == 11) ga = GemmArgs{H, DM, (const u16*)(p.ws + OFF_WT_OUT1), 1024, 4, 1, Bm};
        else ga = GemmArgs{Abuf, DFF, (const u16*)(p.ws + OFF_WT_DN1), 2816, 4, 1, Hm};
        phase_gemm<EPI_M>(p, ga, lds);
      } break;
      default: break;
    }
  }
}

extern "C" void kernel_launch(void* const* d_in, const int* in_sizes, int n_in, void* d_out, int out_size,
                              void* d_ws, size_t ws_size, hipStream_t stream) {
  static int grid_blocks = 0;
  if (!grid_blocks) {
    int dev = 0, cus = 0, per_cu = 0;
    hipGetDevice(&dev);
    hipDeviceGetAttribute(&cus, hipDeviceAttributeMultiprocessorCount, dev);
    hipOccupancyMaxActiveBlocksPerMultiprocessor(&per_cu, mega, NTHR, 0);
    if (per_cu < 1) per_cu = 1;
    if (per_cu > 1) per_cu = 1;
    grid_blocks = cus * per_cu;
    if (grid_blocks > 256) grid_blocks = 256;
    if (grid_blocks < 1) grid_blocks = 1;
  }
  if (ws_size < WS_NEEDED) fprintf(stderr, "workspace too small: %zu < %zu\n", ws_size, (size_t)WS_NEEDED);
  Params p{};
  p.x_prompt = (const float*)d_in[0]; p.x_sample = (const float*)d_in[1];
  p.c_prompt = (const float*)d_in[2]; p.c_sample = (const float*)d_in[3];
  p.ada_w = (const float*)d_in[4]; p.ada_b = (const float*)d_in[5]; p.norm_g = (const float*)d_in[6];
  p.even_w_in = (const float*)d_in[7]; p.even_w_out = (const float*)d_in[8];
  p.diff_lambda = (const float*)d_in[9]; p.diff_subln_g = (const float*)d_in[10]; p.gqa_qk_g = (const float*)d_in[11];
  p.odd_w_qkv = (const float*)d_in[12]; p.odd_rpb = (const float*)d_in[13]; p.odd_w_out = (const float*)d_in[14];
  p.ffn_w_up = (const float*)d_in[15]; p.ffn_conv_w = (const float*)d_in[16]; p.ffn_conv_b = (const float*)d_in[17];
  p.ffn_w_down = (const float*)d_in[18]; p.final_g = (const float*)d_in[19];
  p.out = (float*)d_out;
  p.ws = (char*)d_ws;
#if ONE_LAUNCH
  int ph0 = 0, ph1 = NPHASE;
  void* args[] = {&p, &ph0, &ph1};
  hipError_t e = hipLaunchCooperativeKernel((void*)mega, dim3(grid_blocks), dim3(NTHR), args, 0, stream);
  if (e != hipSuccess) fprintf(stderr, "cooperative launch failed: %s (grid %d)\n", hipGetErrorString(e), grid_blocks);
#else
  for (int ph = 0; ph < NPHASE; ++ph) mega<<<dim3(grid_blocks), dim3(NTHR), 0, stream>>>(p, ph, ph + 1);
#endif
}
```
